# Optimizing an MI355X kernel written in HIP

```python
import math
import jax, jax.numpy as jnp
from jax import lax
import numpy as np

D_MODEL = 1024
BATCH = 16
SEQ = 2048
DEPTH = 1

D_MIX = D_MODEL
CONV_CH = D_MIX // 2
CONV_GROUPS = 8
CONV_K = 31
FOX_HEADS = 8
FOX_HEAD_DIM = 64
FOX_W = FOX_HEADS * FOX_HEAD_DIM
Q_BLOCK = 128
MEM_LEN = 256
MEM_HEADS = 4
MEM_HEAD_DIM = D_MODEL // MEM_HEADS
D_FF = ((8 * D_MODEL // 3 + 255) // 256) * 256
EPS = 1e-6

OFF_U = 0
OFF_G = OFF_U + CONV_CH
OFF_Q = OFF_G + CONV_CH
OFF_K = OFF_Q + FOX_W
OFF_V = OFF_K + FOX_W
OFF_F = OFF_V + FOX_W
D_IN = OFF_F + FOX_HEADS

kernel_name = "hybrid_conformer_fox_memory_block"


def rmsnorm(x, g):
    xf = x.astype(jnp.float32)
    y = xf * lax.rsqrt(jnp.mean(xf * xf, axis=-1, keepdims=True) + EPS)
    return (y * g.astype(jnp.float32)).astype(x.dtype)


def layernorm(x, g, b):
    xf = x.astype(jnp.float32)
    mu = jnp.mean(xf, axis=-1, keepdims=True)
    xc = xf - mu
    y = xc * lax.rsqrt(jnp.mean(xc * xc, axis=-1, keepdims=True) + EPS)
    return (y * g.astype(jnp.float32) + b.astype(jnp.float32)).astype(x.dtype)


def conformer_conv(u, gate, conv_w, conv_b, ln_g, ln_b):
    a = u * jax.nn.sigmoid(gate)
    y = lax.conv_general_dilated(
        a, conv_w[:, None, :].astype(a.dtype),
        window_strides=(1,), padding=[(CONV_K - 1, 0)],
        dimension_numbers=("NWC", "WIO", "NWC"),
        feature_group_count=CONV_CH) + conv_b.astype(a.dtype)
    return jax.nn.silu(layernorm(y, ln_g, ln_b))


def forgetting_attention(q, k, v, logf):
    b, s, h, dh = q.shape
    scale = 1.0 / math.sqrt(dh)
    qh = jnp.transpose(q, (0, 2, 1, 3))
    kh = jnp.transpose(k, (0, 2, 1, 3))
    vh = jnp.transpose(v, (0, 2, 1, 3))
    c = jnp.transpose(jnp.cumsum(logf, axis=1), (0, 2, 1))
    outs = []
    for i in range(s // Q_BLOCK):
        q0, end = i * Q_BLOCK, (i + 1) * Q_BLOCK
        logits = jnp.einsum("bhqd,bhkd->bhqk", qh[:, :, q0:end], kh[:, :, :end],
                            preferred_element_type=jnp.float32) * scale
        logits = logits + (c[:, :, q0:end, None] - c[:, :, None, :end])
        causal = jnp.arange(end)[None, :] <= (q0 + jnp.arange(Q_BLOCK))[:, None]
        logits = jnp.where(causal[None, None], logits, -jnp.inf)
        p = jax.nn.softmax(logits, axis=-1)
        outs.append(jnp.einsum("bhqk,bhkd->bhqd", p.astype(vh.dtype), vh[:, :, :end]))
    o = jnp.concatenate(outs, axis=2)
    return jnp.transpose(o, (0, 2, 1, 3)).reshape(b, s, h * dh)


def memory_cross_attention(hx, mem_n, w_mq, w_mkv, w_mo):
    b, s, _ = hx.shape
    m = mem_n.shape[1]
    q = (hx @ w_mq).reshape(b, s, MEM_HEADS, MEM_HEAD_DIM)
    kv = mem_n @ w_mkv
    k = kv[..., :D_MODEL].reshape(b, m, MEM_HEADS, MEM_HEAD_DIM)
    v = kv[..., D_MODEL:].reshape(b, m, MEM_HEADS, MEM_HEAD_DIM)
    logits = jnp.einsum("bshd,bmhd->bhsm", q, k,
                        preferred_element_type=jnp.float32) / math.sqrt(MEM_HEAD_DIM)
    p = jax.nn.softmax(logits, axis=-1)
    o = jnp.einsum("bhsm,bmhd->bshd", p.astype(v.dtype), v).reshape(b, s, D_MODEL)
    return o @ w_mo


def setup_inputs(seed: int = 0) -> dict:
    key = jax.random.key(seed)
    ks = jax.random.split(key, 24)
    f32 = jnp.float32

    def nrm(k, shape, fan_in):
        return jax.random.normal(k, shape, f32) * (fan_in ** -0.5)

    def gain(k, shape):
        return 1.0 + 0.02 * jax.random.normal(k, shape, f32)

    def small(k, shape, s=0.02):
        return s * jax.random.normal(k, shape, f32)

    return {
        "x": jax.random.normal(ks[0], (BATCH, SEQ, D_MODEL), f32),
        "mem": jax.random.normal(ks[1], (BATCH, MEM_LEN, D_MODEL), f32),
        "g_mix": gain(ks[2], (DEPTH, D_MODEL)),
        "w_in": nrm(ks[3], (DEPTH, D_MODEL, D_IN), D_MODEL),
        "b_f": 2.0 + small(ks[4], (DEPTH, FOX_HEADS), 0.5),
        "conv_w": nrm(ks[5], (DEPTH, CONV_K, CONV_CH), CONV_K),
        "conv_b": small(ks[6], (DEPTH, CONV_CH)),
        "ln_g": gain(ks[7], (DEPTH, CONV_CH)),
        "ln_b": small(ks[8], (DEPTH, CONV_CH)),
        "w_out": nrm(ks[9], (DEPTH, D_MIX, D_MODEL), D_MIX),
        "g_x": gain(ks[10], (DEPTH, D_MODEL)),
        "g_mem": gain(ks[11], (D_MODEL,)),
        "w_mq": nrm(ks[12], (DEPTH, D_MODEL, D_MODEL), D_MODEL),
        "w_mkv": nrm(ks[13], (DEPTH, D_MODEL, 2 * D_MODEL), D_MODEL),
        "w_mo": nrm(ks[14], (DEPTH, D_MODEL, D_MODEL), D_MODEL),
        "g_ffn": gain(ks[15], (DEPTH, D_MODEL)),
        "w_gu": nrm(ks[16], (DEPTH, D_MODEL, 2 * D_FF), D_MODEL),
        "w_down": nrm(ks[17], (DEPTH, D_FF, D_MODEL), D_FF),
        "g_final": gain(ks[18], (D_MODEL,)),
    }


def reference(x, mem, g_mix, w_in, b_f, conv_w, conv_b, ln_g, ln_b, w_out,
              g_x, g_mem, w_mq, w_mkv, w_mo, g_ffn, w_gu, w_down, g_final):
    b, s, _ = x.shape
    mem_n = rmsnorm(mem, g_mem)
    for l in range(DEPTH):
        h = rmsnorm(x, g_mix[l])
        z = h @ w_in[l]
        conv_out = conformer_conv(z[..., OFF_U:OFF_G], z[..., OFF_G:OFF_Q],
                                  conv_w[l], conv_b[l], ln_g[l], ln_b[l])
        q = z[..., OFF_Q:OFF_K].reshape(b, s, FOX_HEADS, FOX_HEAD_DIM)
        k = z[..., OFF_K:OFF_V].reshape(b, s, FOX_HEADS, FOX_HEAD_DIM)
        v = z[..., OFF_V:OFF_F].reshape(b, s, FOX_HEADS, FOX_HEAD_DIM)
        logf = jax.nn.log_sigmoid((z[..., OFF_F:] + b_f[l]).astype(jnp.float32))
        att_out = forgetting_attention(q, k, v, logf)
        x = x + jnp.concatenate([conv_out, att_out], axis=-1) @ w_out[l]
        x = x + memory_cross_attention(rmsnorm(x, g_x[l]), mem_n, w_mq[l], w_mkv[l], w_mo[l])
        gu = rmsnorm(x, g_ffn[l]) @ w_gu[l]
        x = x + (jax.nn.silu(gu[..., :D_FF]) * gu[..., D_FF:]) @ w_down[l]
    return rmsnorm(x, g_final)
```

```cpp
#include <hip/hip_runtime.h>
#include <hip/hip_cooperative_groups.h>
#include <hip/hip_bf16.h>
#include <cstdio>
#include <cstdint>
#include <cmath>
namespace cg = cooperative_groups;

constexpr int NB = 16, SEQ = 2048, DM = 1024, T = NB * SEQ, DIN = 2568, DFF = 2816, ML = 256;
constexpr int ZP = 2560;
constexpr float EPS = 1e-6f, LOG2E = 1.4426950408889634f;

namespace pg8 {
#define PG8_LAS __attribute__((address_space(3)))
typedef unsigned short bf16_t;
typedef short bf16x8 __attribute__((ext_vector_type(8)));
typedef float f32x4 __attribute__((ext_vector_type(4)));
typedef float f32x2 __attribute__((ext_vector_type(2)));
typedef unsigned u32x4 __attribute__((ext_vector_type(4)));
constexpr int BM = 256, BK = 64, HALF = 128, HTB = HALF * BK * 2, STAGE_BYTES = 8 * HTB, NXCD = 8, WGM = 8;

__host__ __device__ __forceinline__ int lds_byte(int r, int c) { const int st = (r >> 4) * 2 + (c >> 5), rr = r & 15, cc = c & 31, ob = rr * 64 + cc * 2; return st * 1024 + (ob ^ (((ob >> 9) & 1) << 5)); }
__host__ __device__ __forceinline__ void stage_rc(int b, int& R, int& C) { const int st = b / 1024, sb = b % 1024, swz = sb ^ (((sb >> 9) & 1) << 5); R = (st >> 1) * 16 + swz / 64; C = (st & 1) * 32 + (swz % 64) / 2; }
__host__ __device__ __forceinline__ int perm32(int rho) { const int n = rho >> 4, i = rho & 15; return 8 * (i >> 2) + 4 * n + (i & 3); }

struct Unit { size_t aoff, boff; int r0, c0, sel; };
struct Gemm { const bf16_t* A; const bf16_t* Bt; int lda, ldb, K; };

__device__ __forceinline__ int xcd_remap(int L, int nwg) { const int q = nwg / NXCD, r = nwg % NXCD, xcd = L % NXCD, off = L / NXCD; return (xcd < r ? xcd * (q + 1) : r * (q + 1) + (xcd - r) * q) + off; }

struct Sched2D {
    int nM, nN, nwg, G, c, perm; size_t atile, btile, bbatch;
    __device__ void init(int M, int N, int G_, int c_, int lda, int ldb, size_t bbatch_ = 0, int perm_ = 0) { nM = M / BM; nN = N / BM; nwg = nM * nN; G = G_; c = c_; perm = perm_; atile = (size_t)BM * lda * 2; btile = (size_t)BM * ldb * 2; bbatch = bbatch_; }
    __device__ bool next(int i, Unit& u) const {
        const long L = (long)i * G + c; if (L >= nwg) return false;
        const int wgid = xcd_remap((int)L, nwg);
        const int nig = WGM * nN, gid = wgid / nig, fm = gid * WGM, gsz = (nM - fm) < WGM ? (nM - fm) : WGM;
        int pm = fm + ((wgid % nig) % gsz); const int pn = (wgid % nig) / gsz;
        if (perm) { const int x = pm >> 4, j = pm & 15; pm = (j < 8) ? 8 * x + j : 64 + 8 * x + (j - 8); } u.aoff = (size_t)pm * atile; u.boff = (size_t)pn * btile + (size_t)(pm >> 3) * bbatch; u.r0 = pm * BM; u.c0 = pn * BM; u.sel = 0; return true;
    }
};
struct SchedKV {
    int G, c; size_t oKVM, oWMQ, oWMO;
    __device__ void init(int G_, int c_, size_t kvm, size_t wmq, size_t wmo) { G = G_; c = c_; oKVM = kvm; oWMQ = wmq; oWMO = wmo; }
    __device__ bool next(int i, Unit& u) const {
        const long L = (long)i * G + c; if (L >= 512) return false;
        const int sel = (int)(L >> 8); const int w = xcd_remap((int)(L & 255), 256); const int z = w >> 2, t4 = w & 3, b = z >> 2, h = z & 3;
        u.sel = sel;
        if (sel == 0) { u.aoff = oKVM + ((size_t)(b * ML) * 2048 + h * 256) * 2; u.boff = oWMQ + ((size_t)(t4 * 256) * 2048 + h * 256) * 2; u.r0 = b * DM + h * 256; u.c0 = t4 * 256; }
        else { u.aoff = oWMO + ((size_t)(t4 * 256) * 2048 + h * 256) * 2; u.boff = oKVM + ((size_t)(b * ML) * 2048 + DM + h * 256) * 2; u.r0 = b * DM + t4 * 256; u.c0 = h * 256; }
        return true;
    }
};

__device__ __forceinline__ unsigned cvt_pk_bf16(float lo, float hi) { unsigned r; asm volatile("v_cvt_pk_bf16_f32 %0, %1, %2" : "=v"(r) : "v"(lo), "v"(hi)); return r; }
__device__ __forceinline__ u32x4 pack8(f32x4 v0, f32x4 v1) { u32x4 w; w.x = cvt_pk_bf16(v0[0], v0[1]); w.y = cvt_pk_bf16(v0[2], v0[3]); w.z = cvt_pk_bf16(v1[0], v1[1]); w.w = cvt_pk_bf16(v1[2], v1[3]); return w; }

typedef f32x4 Acc[2][2][4][2];
struct EpiBf16 {
    bf16_t* O; int ldc; int sc_lo, sc_hi; float sc;
    __device__ __forceinline__ void operator()(Acc& acc, const Unit& u, int wr, int wc, int fr, int fq, PG8_LAS unsigned char*) const {
        const float s = (u.c0 >= sc_lo && u.c0 < sc_hi) ? sc : 1.f;
        bf16_t* base = O + (size_t)(u.r0 + wr * 64 + fr) * ldc + u.c0 + wc * 32 + 8 * fq;
#pragma unroll
        for (int ai = 0; ai < 2; ++ai)
#pragma unroll
            for (int m = 0; m < 4; ++m) { bf16_t* rowp = base + (size_t)(ai * HALF + m * 16) * ldc;
#pragma unroll
                for (int bj = 0; bj < 2; ++bj) *(u32x4*)(rowp + bj * HALF) = pack8(acc[ai][bj][m][0] * s, acc[ai][bj][m][1] * s); }
    }
};
struct EpiBf16x2 {
    bf16_t* O0; bf16_t* O1; int ldc; float sc0;
    __device__ __forceinline__ void operator()(Acc& acc, const Unit& u, int wr, int wc, int fr, int fq, PG8_LAS unsigned char*) const {
        const float s = u.sel ? 1.f : sc0;
        bf16_t* base = (u.sel ? O1 : O0) + (size_t)(u.r0 + wr * 64 + fr) * ldc + u.c0 + wc * 32 + 8 * fq;
#pragma unroll
        for (int ai = 0; ai < 2; ++ai)
#pragma unroll
            for (int m = 0; m < 4; ++m) { bf16_t* rowp = base + (size_t)(ai * HALF + m * 16) * ldc;
#pragma unroll
                for (int bj = 0; bj < 2; ++bj) *(u32x4*)(rowp + bj * HALF) = pack8(acc[ai][bj][m][0] * s, acc[ai][bj][m][1] * s); }
    }
};
struct EpiZ {
    bf16_t* O; int ldc; float sc;
    __device__ __forceinline__ void operator()(Acc& acc, const Unit& u, int wr, int wc, int fr, int fq, PG8_LAS unsigned char*) const {
        if (u.c0 < 1024) {
            bf16_t* base = O + (size_t)(u.r0 + wr * 64 + fr) * ldc + (u.c0 >> 1) + wc * 32 + 8 * fq;
#pragma unroll
            for (int ai = 0; ai < 2; ++ai)
#pragma unroll
                for (int m = 0; m < 4; ++m) { f32x4 o[2];
#pragma unroll
                    for (int n = 0; n < 2; ++n) { const f32x4 uu = acc[ai][0][m][n], g = acc[ai][1][m][n]; f32x4 r;
#pragma unroll
                        for (int e = 0; e < 4; ++e) r[e] = uu[e] * __builtin_amdgcn_rcpf(1.f + __builtin_amdgcn_exp2f(-LOG2E * g[e]));
                        o[n] = r; }
                    *(u32x4*)(base + (size_t)(ai * HALF + m * 16) * ldc) = pack8(o[0], o[1]); }
        } else {
            const float s = (u.c0 < 1536) ? sc : 1.f;
            bf16_t* base = O + (size_t)(u.r0 + wr * 64 + fr) * ldc + u.c0 + wc * 32 + 8 * fq;
#pragma unroll
            for (int ai = 0; ai < 2; ++ai)
#pragma unroll
                for (int m = 0; m < 4; ++m) { bf16_t* rowp = base + (size_t)(ai * HALF + m * 16) * ldc;
#pragma unroll
                    for (int bj = 0; bj < 2; ++bj) *(u32x4*)(rowp + bj * HALF) = pack8(acc[ai][bj][m][0] * s, acc[ai][bj][m][1] * s); }
        }
    }
};
__device__ __forceinline__ void unpack8(u32x4 w, f32x4& v0, f32x4& v1) {
    v0 = (f32x4){__uint_as_float(w.x << 16), __uint_as_float(w.x & 0xffff0000u), __uint_as_float(w.y << 16), __uint_as_float(w.y & 0xffff0000u)};
    v1 = (f32x4){__uint_as_float(w.z << 16), __uint_as_float(w.z & 0xffff0000u), __uint_as_float(w.w << 16), __uint_as_float(w.w & 0xffff0000u)};
}
template <bool BASE_BF16> struct EpiRes {
    const void* base; bf16_t* outB; float* SS;
    __device__ __forceinline__ void operator()(Acc& acc, const Unit& u, int wr, int wc, int fr, int fq, PG8_LAS unsigned char* xl) const {
        PG8_LAS float* X = (PG8_LAS float*)xl;
        const int col = u.c0 + wc * 32 + 8 * fq;
#pragma unroll
        for (int ai = 0; ai < 2; ++ai)
#pragma unroll
            for (int m = 0; m < 4; ++m) { const int rl = ai * HALF + wr * 64 + m * 16 + fr; const int row = u.r0 + rl; const size_t off = (size_t)row * DM + col; float s = 0.f;
#pragma unroll
                for (int bj = 0; bj < 2; ++bj) {
                    f32x4 b0, b1;
                    if (BASE_BF16) unpack8(*(const u32x4*)((const bf16_t*)base + off + bj * HALF), b0, b1);
                    else { b0 = *(const f32x4*)((const float*)base + off + bj * HALF); b1 = *(const f32x4*)((const float*)base + off + bj * HALF + 4); }
                    const u32x4 w = pack8(acc[ai][bj][m][0] + b0, acc[ai][bj][m][1] + b1);
                    *(u32x4*)(outB + off + bj * HALF) = w;
                    f32x4 v0, v1; unpack8(w, v0, v1);
                    s += (v0[0] * v0[0] + v0[1] * v0[1]) + (v0[2] * v0[2] + v0[3] * v0[3]) + (v1[0] * v1[0] + v1[1] * v1[1]) + (v1[2] * v1[2] + v1[3] * v1[3]); }
                s += __shfl_xor(s, 16); s += __shfl_xor(s, 32);
                if (fq == 0) X[rl * 4 + wc] = s; }
        asm volatile("s_waitcnt lgkmcnt(0)" ::: "memory"); __builtin_amdgcn_s_barrier(); asm volatile("" ::: "memory");
        const int tid = threadIdx.x;
        if (tid < 256) SS[(size_t)(u.r0 + tid) * 4 + (u.c0 >> 8)] = (X[tid * 4 + 0] + X[tid * 4 + 1]) + (X[tid * 4 + 2] + X[tid * 4 + 3]);
    }
};
__device__ __forceinline__ const PG8_LAS float* rs_table(const float* SS, int r0, PG8_LAS unsigned char* xl) {
    PG8_LAS float* S = (PG8_LAS float*)(xl + 8192 + 256); const int tid = threadIdx.x;
    if (tid < 256) { const f32x4 p = *(const f32x4*)(SS + (size_t)(r0 + tid) * 4); S[tid] = 1.0f / sqrtf(((p[0] + p[1]) + (p[2] + p[3])) * (1.f / DM) + EPS); }
    asm volatile("s_waitcnt vmcnt(0) lgkmcnt(0)" ::: "memory"); __builtin_amdgcn_s_barrier(); asm volatile("" ::: "memory");
    return S;
}
struct EpiRs {
    bf16_t* O; int ldc; const float* SS; float sc;
    __device__ __forceinline__ void operator()(Acc& acc, const Unit& u, int wr, int wc, int fr, int fq, PG8_LAS unsigned char* xl) const {
        const PG8_LAS float* S = rs_table(SS, u.r0, xl);
#pragma unroll
        for (int ai = 0; ai < 2; ++ai)
#pragma unroll
            for (int m = 0; m < 4; ++m) { const int rl = ai * HALF + wr * 64 + m * 16 + fr; const int row = u.r0 + rl; const float s = S[rl] * sc;
                bf16_t* rowp = O + (size_t)row * ldc + u.c0 + wc * 32 + 8 * fq;
#pragma unroll
                for (int bj = 0; bj < 2; ++bj) *(u32x4*)(rowp + bj * HALF) = pack8(acc[ai][bj][m][0] * s, acc[ai][bj][m][1] * s); }
    }
};
struct EpiSwiGLU {
    bf16_t* H; int ldc; const float* SS;
    __device__ __forceinline__ void operator()(Acc& acc, const Unit& u, int wr, int wc, int fr, int fq, PG8_LAS unsigned char* xl) const {
        const PG8_LAS float* S = rs_table(SS, u.r0, xl);
#pragma unroll
        for (int ai = 0; ai < 2; ++ai)
#pragma unroll
            for (int m = 0; m < 4; ++m) { const int rl = ai * HALF + wr * 64 + m * 16 + fr; const int row = u.r0 + rl; const float s = S[rl];
                f32x4 o[2];
#pragma unroll
                for (int n = 0; n < 2; ++n) { const f32x4 g = acc[ai][0][m][n] * s, up = acc[ai][1][m][n] * s; f32x4 r;
#pragma unroll
                    for (int e = 0; e < 4; ++e) r[e] = g[e] * __builtin_amdgcn_rcpf(1.f + __builtin_amdgcn_exp2f(-LOG2E * g[e])) * up[e];
                    o[n] = r; }
                *(u32x4*)(H + (size_t)row * ldc + (u.c0 >> 1) + wc * 32 + 8 * fq) = pack8(o[0], o[1]); }
    }
};
struct EpiSoftmax {
    bf16_t* P; int ldc; const float* SS;
    __device__ __forceinline__ void operator()(Acc& acc, const Unit& u, int wr, int wc, int fr, int fq, PG8_LAS unsigned char* xl) const {
        const PG8_LAS float* S = rs_table(SS, u.r0, xl);
        PG8_LAS f32x2* X = (PG8_LAS f32x2*)xl;
#pragma unroll
        for (int ai = 0; ai < 2; ++ai)
#pragma unroll
            for (int m = 0; m < 4; ++m) { const int rl = ai * HALF + wr * 64 + m * 16 + fr; const float rs = S[rl];
                float mx = -INFINITY;
#pragma unroll
                for (int bj = 0; bj < 2; ++bj)
#pragma unroll
                    for (int n = 0; n < 2; ++n) { const f32x4 v = acc[ai][bj][m][n] * rs; acc[ai][bj][m][n] = v; mx = fmaxf(mx, fmaxf(fmaxf(v[0], v[1]), fmaxf(v[2], v[3]))); }
                mx = fmaxf(mx, __shfl_xor(mx, 16)); mx = fmaxf(mx, __shfl_xor(mx, 32));
                float s = 0.f;
#pragma unroll
                for (int bj = 0; bj < 2; ++bj)
#pragma unroll
                    for (int n = 0; n < 2; ++n) { f32x4 v = acc[ai][bj][m][n];
#pragma unroll
                        for (int e = 0; e < 4; ++e) { v[e] = __builtin_amdgcn_exp2f(v[e] - mx); s += v[e]; }
                        acc[ai][bj][m][n] = v; }
                s += __shfl_xor(s, 16); s += __shfl_xor(s, 32);
                if (fq == 0) X[rl * 4 + wc] = (f32x2){mx, s};
            }
        asm volatile("s_waitcnt lgkmcnt(0)" ::: "memory"); __builtin_amdgcn_s_barrier(); asm volatile("" ::: "memory");
#pragma unroll
        for (int ai = 0; ai < 2; ++ai)
#pragma unroll
            for (int m = 0; m < 4; ++m) { const int rl = ai * HALF + wr * 64 + m * 16 + fr;
                const f32x2 a = X[rl * 4 + 0], b = X[rl * 4 + 1], c = X[rl * 4 + 2], d = X[rl * 4 + 3];
                const float M = fmaxf(fmaxf(a.x, b.x), fmaxf(c.x, d.x));
                const float tot = a.y * __builtin_amdgcn_exp2f(a.x - M) + b.y * __builtin_amdgcn_exp2f(b.x - M) + c.y * __builtin_amdgcn_exp2f(c.x - M) + d.y * __builtin_amdgcn_exp2f(d.x - M);
                const float own = wc == 0 ? a.x : wc == 1 ? b.x : wc == 2 ? c.x : d.x;
                const float f = __builtin_amdgcn_exp2f(own - M) / tot;
                bf16_t* rowp = P + (size_t)(u.r0 + rl) * ldc + u.c0 + wc * 32 + 8 * fq;
#pragma unroll
                for (int bj = 0; bj < 2; ++bj) *(u32x4*)(rowp + bj * HALF) = pack8(acc[ai][bj][m][0] * f, acc[ai][bj][m][1] * f); }
    }
};
struct EpiFinal {
    const bf16_t* base; float* out; const float* gfin; float* SS3; unsigned* cnt;
    __device__ __forceinline__ void operator()(Acc& acc, const Unit& u, int wr, int wc, int fr, int fq, PG8_LAS unsigned char* xl) const {
        PG8_LAS float* X = (PG8_LAS float*)xl;
        PG8_LAS float* S = X + 1024;
        const int tid = threadIdx.x, lane = tid & 63, wid = __builtin_amdgcn_readfirstlane(tid >> 6);
        const int col = u.c0 + wc * 32 + 8 * fq;
#pragma unroll
        for (int ai = 0; ai < 2; ++ai)
#pragma unroll
            for (int m = 0; m < 4; ++m) { const int rl = ai * HALF + wr * 64 + m * 16 + fr; const size_t off = (size_t)(u.r0 + rl) * DM + col; float s = 0.f;
#pragma unroll
                for (int bj = 0; bj < 2; ++bj) {
                    f32x4 b0, b1; unpack8(*(const u32x4*)(base + off + bj * HALF), b0, b1);
                    const f32x4 v0 = acc[ai][bj][m][0] + b0, v1 = acc[ai][bj][m][1] + b1;
                    acc[ai][bj][m][0] = v0; acc[ai][bj][m][1] = v1;
                    s += (v0[0] * v0[0] + v0[1] * v0[1]) + (v0[2] * v0[2] + v0[3] * v0[3]) + (v1[0] * v1[0] + v1[1] * v1[1]) + (v1[2] * v1[2] + v1[3] * v1[3]); }
                s += __shfl_xor(s, 16); s += __shfl_xor(s, 32);
                if (fq == 0) X[rl * 4 + wc] = s; }
        asm volatile("s_waitcnt lgkmcnt(0)" ::: "memory"); __builtin_amdgcn_s_barrier(); asm volatile("" ::: "memory");
        const int panel = u.r0 >> 8; unsigned* pc = cnt + 64 * panel;
        if (tid < 256) { const float tot = (X[tid * 4 + 0] + X[tid * 4 + 1]) + (X[tid * 4 + 2] + X[tid * 4 + 3]);
            __hip_atomic_store(SS3 + (size_t)(u.r0 + tid) * 4 + (u.c0 >> 8), tot, __ATOMIC_RELAXED, __HIP_MEMORY_SCOPE_AGENT); }
        asm volatile("s_waitcnt vmcnt(0)" ::: "memory");
        if (tid < 256 && lane == 0) __hip_atomic_fetch_add(pc, 1u, __ATOMIC_RELAXED, __HIP_MEMORY_SCOPE_AGENT);
        if (wid == 0) { unsigned sp = 0;
            while ((unsigned)__builtin_amdgcn_readfirstlane(__hip_atomic_load(pc, __ATOMIC_RELAXED, __HIP_MEMORY_SCOPE_AGENT)) < 16u) { __builtin_amdgcn_s_sleep(1); if (++sp > (1u << 22)) break; }
            __builtin_amdgcn_fence(__ATOMIC_ACQUIRE, "agent"); }
        asm volatile("s_waitcnt vmcnt(0) lgkmcnt(0)" ::: "memory"); __builtin_amdgcn_s_barrier(); asm volatile("" ::: "memory");
        if (tid < 256) { const float* sl = SS3 + (size_t)(u.r0 + tid) * 4;
            const float q = (__hip_atomic_load(sl + 0, __ATOMIC_RELAXED, __HIP_MEMORY_SCOPE_AGENT) + __hip_atomic_load(sl + 1, __ATOMIC_RELAXED, __HIP_MEMORY_SCOPE_AGENT))
                          + (__hip_atomic_load(sl + 2, __ATOMIC_RELAXED, __HIP_MEMORY_SCOPE_AGENT) + __hip_atomic_load(sl + 3, __ATOMIC_RELAXED, __HIP_MEMORY_SCOPE_AGENT));
            S[tid] = 1.0f / sqrtf(q * (1.f / DM) + EPS); }
        asm volatile("s_waitcnt vmcnt(0) lgkmcnt(0)" ::: "memory"); __builtin_amdgcn_s_barrier(); asm volatile("" ::: "memory");
        f32x4 gv[2][2];
#pragma unroll
        for (int bj = 0; bj < 2; ++bj) { gv[bj][0] = *(const f32x4*)(gfin + col + bj * HALF); gv[bj][1] = *(const f32x4*)(gfin + col + bj * HALF + 4); }
#pragma unroll
        for (int ai = 0; ai < 2; ++ai)
#pragma unroll
            for (int m = 0; m < 4; ++m) { const int rl = ai * HALF + wr * 64 + m * 16 + fr; const float rs = S[rl]; const size_t off = (size_t)(u.r0 + rl) * DM + col;
#pragma unroll
                for (int bj = 0; bj < 2; ++bj) { *(f32x4*)(out + off + bj * HALF) = acc[ai][bj][m][0] * rs * gv[bj][0]; *(f32x4*)(out + off + bj * HALF + 4) = acc[ai][bj][m][1] * rs * gv[bj][1]; } }
    }
};

struct EpiResF32 {
    const bf16_t* base; float* out;
    __device__ __forceinline__ void operator()(Acc& acc, const Unit& u, int wr, int wc, int fr, int fq, PG8_LAS unsigned char*) const {
        const int col = u.c0 + wc * 32 + 8 * fq;
#pragma unroll
        for (int ai = 0; ai < 2; ++ai)
#pragma unroll
            for (int m = 0; m < 4; ++m) { const size_t off = (size_t)(u.r0 + ai * HALF + wr * 64 + m * 16 + fr) * DM + col;
#pragma unroll
                for (int bj = 0; bj < 2; ++bj) { f32x4 b0, b1; unpack8(*(const u32x4*)(base + off + bj * HALF), b0, b1);
                    *(f32x4*)(out + off + bj * HALF) = acc[ai][bj][m][0] + b0; *(f32x4*)(out + off + bj * HALF + 4) = acc[ai][bj][m][1] + b1; } }
    }
};
template <class Epi, class Sched>
__device__ __forceinline__ void gemm_phase(PG8_LAS unsigned char* lds, PG8_LAS unsigned char* xl, const Gemm g, const Sched& S, const Epi& E) {
    int tid_ = threadIdx.x; asm volatile("" : "+v"(tid_));
    const int tid = tid_, wid = __builtin_amdgcn_readfirstlane(tid >> 6), lane = tid & 63, wr = wid >> 2, wc = wid & 3, fr = lane & 15, fq = lane >> 4;
    const int K = g.K, nt = K / BK;
    unsigned voffA[2], voffB[2];
#pragma unroll
    for (int i = 0; i < 2; ++i) { int R, C; stage_rc(tid * 16 + i * 8192, R, C); const int Rb = (R & ~31) + perm32(R & 31);
        voffA[i] = (unsigned)(R * g.lda + C) * 2u; voffB[i] = (unsigned)(Rb * g.ldb + C) * 2u; }
    const size_t kstep = (size_t)(BK * 2);
    const size_t hsA = (size_t)HALF * g.lda * 2, hsB = (size_t)HALF * g.ldb * 2;
    const unsigned ldsw = (unsigned)wid * 1024u;
    const int aoff = lds_byte(wr * 64 + fr, fq * 8), boff = lds_byte(wc * 32 + fr, fq * 8);
#define PG8_SA(b, h) (((b) * 2 + (h)) * HTB)
#define PG8_SB(b, h) ((4 + (b) * 2 + (h)) * HTB)
#define PG8_STAGE(bufoff, gbase, voff) do { _Pragma("unroll") for (int _i = 0; _i < 2; ++_i) \
        __builtin_amdgcn_global_load_lds((const unsigned*)((const char*)(gbase) + (voff)[_i]), (PG8_LAS unsigned*)(lds + (bufoff) + ldsw + _i * 8192), 16, 0, 0); } while (0)
#define PG8_LDA(dst, b, h) do { _Pragma("unroll") for (int m = 0; m < 4; ++m) _Pragma("unroll") for (int k = 0; k < 2; ++k) dst[m][k] = *(const PG8_LAS bf16x8*)(lds + PG8_SA(b, h) + aoff + m * 2048 + k * 1024); } while (0)
#define PG8_LDB(dst, b, h) do { _Pragma("unroll") for (int n = 0; n < 2; ++n) _Pragma("unroll") for (int k = 0; k < 2; ++k) dst[n][k] = *(const PG8_LAS bf16x8*)(lds + PG8_SB(b, h) + boff + n * 2048 + k * 1024); } while (0)
#define PG8_MMA(ai, bj, At, Bt) do { __builtin_amdgcn_s_setprio(1); _Pragma("unroll") for (int m = 0; m < 4; ++m) _Pragma("unroll") for (int n = 0; n < 2; ++n) _Pragma("unroll") for (int k = 0; k < 2; ++k) \
        acc[ai][bj][m][n] = __builtin_amdgcn_mfma_f32_16x16x32_bf16(Bt[n][k], At[m][k], acc[ai][bj][m][n], 0, 0, 0); __builtin_amdgcn_s_setprio(0); } while (0)
#define PG8_WAIT_V(n) asm volatile("s_waitcnt vmcnt(" #n ")" ::: "memory")
#define PG8_WAIT_L(n) asm volatile("s_waitcnt lgkmcnt(" #n ")" ::: "memory")
#define PG8_BAR __builtin_amdgcn_s_barrier()
#define PG8_SCHED __builtin_amdgcn_sched_barrier(0)
    Unit cur, nxt; int ui = 0;
    if (!S.next(0, cur)) return;
    Acc acc;
#pragma unroll
    for (int a = 0; a < 2; ++a)
#pragma unroll
        for (int b = 0; b < 2; ++b)
#pragma unroll
            for (int m = 0; m < 4; ++m)
#pragma unroll
                for (int n = 0; n < 2; ++n) acc[a][b][m][n] = (f32x4){0.f, 0.f, 0.f, 0.f};
    bf16x8 At[4][2], B0[2][2], B1[2][2];
    const char* cA = (const char*)g.A + cur.aoff; const char* cB = (const char*)g.Bt + cur.boff;
    PG8_STAGE(PG8_SB(0, 0), cB, voffB); PG8_STAGE(PG8_SB(0, 1), cB + hsB, voffB); PG8_STAGE(PG8_SA(0, 0), cA, voffA); PG8_STAGE(PG8_SA(0, 1), cA + hsA, voffA);
    if (wr == 1) PG8_BAR;
    PG8_WAIT_V(2); PG8_BAR;
    PG8_STAGE(PG8_SB(1, 0), cB + kstep, voffB); PG8_STAGE(PG8_SA(1, 0), cA + kstep, voffA); PG8_STAGE(PG8_SB(1, 1), cB + hsB + kstep, voffB);
    PG8_WAIT_V(6); PG8_BAR;
    for (;;) {
        const bool has_next = S.next(ui + 1, nxt);
        const char* nA = has_next ? (const char*)g.A + nxt.aoff : cA; const char* nB = has_next ? (const char*)g.Bt + nxt.boff : cB;
#pragma unroll 1
        for (int t = 0; t < nt; t += 2) {
            const bool last = (t == nt - 2);
            const char* a1 = cA + (size_t)(t + 1) * kstep;
            const char* a2 = last ? nA : cA + (size_t)(t + 2) * kstep; const char* b2 = last ? nB : cB + (size_t)(t + 2) * kstep;
            const char* a3 = a2 + kstep; const char* b3 = b2 + kstep;
            PG8_LDB(B0, 0, 0); PG8_LDB(B1, 0, 1); PG8_SCHED; PG8_LDA(At, 0, 0); PG8_STAGE(PG8_SA(1, 1), a1 + hsA, voffA);
            PG8_WAIT_V(8); PG8_WAIT_L(0); PG8_BAR; PG8_MMA(0, 0, At, B0); PG8_MMA(0, 1, At, B1); PG8_BAR; PG8_SCHED;
            PG8_LDA(At, 0, 1); PG8_STAGE(PG8_SB(0, 0), b2, voffB); PG8_STAGE(PG8_SB(0, 1), b2 + hsB, voffB); PG8_STAGE(PG8_SA(0, 0), a2, voffA);
            PG8_WAIT_V(8); PG8_WAIT_L(0); PG8_BAR; PG8_MMA(1, 0, At, B0); PG8_MMA(1, 1, At, B1); PG8_BAR; PG8_SCHED;
            PG8_LDB(B0, 1, 0); PG8_LDB(B1, 1, 1); PG8_SCHED; PG8_LDA(At, 1, 0); PG8_STAGE(PG8_SA(0, 1), a2 + hsA, voffA);
            PG8_WAIT_V(8); PG8_WAIT_L(0); PG8_BAR; PG8_MMA(0, 0, At, B0); PG8_MMA(0, 1, At, B1); PG8_BAR; PG8_SCHED;
            PG8_LDA(At, 1, 1); PG8_STAGE(PG8_SB(1, 0), b3, voffB); PG8_STAGE(PG8_SB(1, 1), b3 + hsB, voffB); PG8_STAGE(PG8_SA(1, 0), a3, voffA);
            PG8_WAIT_V(8); PG8_WAIT_L(0); PG8_BAR; PG8_MMA(1, 0, At, B0); PG8_MMA(1, 1, At, B1); PG8_BAR; PG8_SCHED;
        }
        if (wr == 0) PG8_BAR;
        E(acc, cur, wr, wc, fr, fq, xl);
        if (!has_next) break;
#pragma unroll
        for (int a = 0; a < 2; ++a)
#pragma unroll
            for (int b = 0; b < 2; ++b)
#pragma unroll
                for (int m = 0; m < 4; ++m)
#pragma unroll
                    for (int n = 0; n < 2; ++n) acc[a][b][m][n] = (f32x4){0.f, 0.f, 0.f, 0.f};
        cur = nxt; cA = nA; cB = nB; ++ui;
        if (wr == 1) PG8_BAR;
    }
    PG8_WAIT_V(0);
    PG8_BAR;
#undef PG8_SA
#undef PG8_SB
#undef PG8_STAGE
#undef PG8_LDA
#undef PG8_LDB
#undef PG8_MMA
#undef PG8_WAIT_V
#undef PG8_WAIT_L
#undef PG8_BAR
#undef PG8_SCHED
}
}

namespace attn_body {
using bf16 = __hip_bfloat16;
using bf16x8 = __attribute__((ext_vector_type(8))) short;
using s16x4 = __attribute__((ext_vector_type(4))) short;
using f32x16 = __attribute__((ext_vector_type(16))) float;
using f32x4 = __attribute__((ext_vector_type(4))) float;
using u32x4 = __attribute__((ext_vector_type(4))) unsigned;
constexpr int D = 64, KP = ZP, OP = DM;
constexpr int NW = 8, QBLK = 32, QB = QBLK * NW, KVBLK = 64;
__device__ __forceinline__ int crow(int r, int hi) { return (r & 3) + 8 * (r >> 2) + 4 * hi; }
#define SBAR() __builtin_amdgcn_sched_barrier(0)
__device__ __forceinline__ void cmask(f32x16& p0, f32x16& p1, int jb, int qrel, int hi) {
    const float NEG = -INFINITY; int kb = 64 * jb + 4 * hi;
#pragma unroll
    for (int r = 0; r < 16; ++r) { int kv = kb + (r & 3) + 8 * (r >> 2); if (kv > qrel) p0[r] = NEG; if (kv + 32 > qrel) p1[r] = NEG; }
}
constexpr int NSLOT = 3, SLOTB = 8192;
constexpr int LDS_K = 0, LDS_V = NSLOT * SLOTB, LDS_WS = 2 * NSLOT * SLOTB, LDS_OST = LDS_WS + NW * 64 * 4, LDS_KX = LDS_OST + NW * 4096, LDS_BYTES = LDS_KX + SEQ * 16 + 16;
constexpr float C2 = 0.125f * 1.4426950408889634f;
__device__ __forceinline__ void glds16(const void* gsrc, unsigned lds_dst) { unsigned keep;
    asm volatile("s_mov_b32 %0, m0\n\ts_mov_b32 m0, %2\n\ts_nop 0\n\tglobal_load_lds_dwordx4 %1, off\n\ts_mov_b32 m0, %0" : "=&s"(keep) : "v"(gsrc), "s"(lds_dst) : "memory"); }
__device__ __forceinline__ float max3f(float a, float b, float c) { float r; asm("v_max3_f32 %0, %1, %2, %3" : "=v"(r) : "v"(a), "v"(b), "v"(c)); return r; }
__device__ __forceinline__ float max2f(float a, float b) { float r; asm("v_max_f32_e32 %0, %1, %2" : "=v"(r) : "v"(a), "v"(b)); return r; }
__device__ __forceinline__ float fadd_s(float a, float b) { float r; asm("v_add_f32_e32 %0, %1, %2" : "=v"(r) : "v"(a), "v"(b)); return r; }
__device__ __forceinline__ float fsub_s(float a, float b) { float r; asm("v_sub_f32_e32 %0, %1, %2" : "=v"(r) : "v"(a), "v"(b)); return r; }
typedef float f32x2_t __attribute__((ext_vector_type(2))); typedef __bf16 bf16x2_t __attribute__((ext_vector_type(2)));
__device__ __forceinline__ unsigned cvtpk_s(float lo, float hi) { f32x2_t v = {lo, hi}; bf16x2_t b = __builtin_convertvector(v, bf16x2_t); return __builtin_bit_cast(unsigned, b); }
#define WAIT_BAR(N) asm volatile("s_waitcnt vmcnt(" #N ") lgkmcnt(0)\n\ts_barrier" ::: "memory")

__device__ __forceinline__ void qkt(f32x16& p0, f32x16& p1, const char* Kslot, const bf16x8* qr, const f32x16& negm, int r32, int hi, bf16x8 kx0, bf16x8 kx1, bf16x8 qx) {
    const char* kb = Kslot + hi * 1024 + r32 * 16;
#pragma unroll
    for (int d0 = 0; d0 < 4; ++d0) {
        const bf16x8 b0 = *reinterpret_cast<const bf16x8*>(kb + d0 * 2048);
        const bf16x8 b1 = *reinterpret_cast<const bf16x8*>(kb + d0 * 2048 + 512);
        if (d0 == 0) { p0 = __builtin_amdgcn_mfma_f32_32x32x16_bf16(b0, qr[0], negm, 0, 0, 0); p1 = __builtin_amdgcn_mfma_f32_32x32x16_bf16(b1, qr[0], negm, 0, 0, 0); }
        else { p0 = __builtin_amdgcn_mfma_f32_32x32x16_bf16(b0, qr[d0], p0, 0, 0, 0); p1 = __builtin_amdgcn_mfma_f32_32x32x16_bf16(b1, qr[d0], p1, 0, 0, 0); } }
    p0 = __builtin_amdgcn_mfma_f32_32x32x16_bf16(kx0, qx, p0, 0, 0, 0); p1 = __builtin_amdgcn_mfma_f32_32x32x16_bf16(kx1, qx, p1, 0, 0, 0);
}
typedef __attribute__((address_space(3))) const char* lds_cptr;
typedef short v4i16_t __attribute__((ext_vector_type(4)));
#define L3BF8 const __attribute__((address_space(3))) bf16x8
__device__ __forceinline__ void kload8(bf16x8* kf, lds_cptr kp) {
    kf[0] = *(L3BF8*)(kp);        kf[1] = *(L3BF8*)(kp + 512);
    kf[2] = *(L3BF8*)(kp + 2048); kf[3] = *(L3BF8*)(kp + 2560);
    kf[4] = *(L3BF8*)(kp + 4096); kf[5] = *(L3BF8*)(kp + 4608);
    kf[6] = *(L3BF8*)(kp + 6144); kf[7] = *(L3BF8*)(kp + 6656);
}
__device__ __forceinline__ void kload2(bf16x8* kf, lds_cptr kp, int j) { kf[2 * j] = *(L3BF8*)(kp + j * 2048); kf[2 * j + 1] = *(L3BF8*)(kp + j * 2048 + 512); }
__device__ __forceinline__ s16x4 vtr(lds_cptr p) { return __builtin_bit_cast(s16x4, __builtin_amdgcn_ds_read_tr16_b64_v4i16((__attribute__((address_space(3))) v4i16_t*)p)); }
__device__ __forceinline__ float rowmax(const f32x16& p0, const f32x16& p1) {
    float a = max3f(p0[0], p0[1], p1[0]), b = max3f(p0[2], p0[3], p1[1]); a = max3f(a, p1[2], p1[3]);
#pragma unroll
    for (int r = 4; r < 16; r += 4) { a = max3f(a, p0[r], p0[r + 1]); b = max3f(b, p0[r + 2], p0[r + 3]); a = max3f(a, p1[r], p1[r + 1]); b = max3f(b, p1[r + 2], p1[r + 3]); }
    const float m = max2f(a, b);
    auto rr = __builtin_amdgcn_permlane32_swap(__float_as_uint(m), __float_as_uint(m), false, false);
    return max2f(__uint_as_float(rr[0]), __uint_as_float(rr[1]));
}
__device__ __forceinline__ void pv(f32x16* o, int vb, bf16x8 pa0, bf16x8 pa1, bf16x8 pa2, bf16x8 pa3) {
#pragma unroll
    for (int d0 = 0; d0 < 2; ++d0) { s16x4 lo[4], hi[4];
#pragma unroll
        for (int ks = 0; ks < 4; ++ks) {
            asm volatile("ds_read_b64_tr_b16 %0,%1 offset:%c2" : "=&v"(lo[ks]) : "v"(vb), "i"(d0 * 4096 + ks * 1024) : "memory");
            asm volatile("ds_read_b64_tr_b16 %0,%1 offset:%c2" : "=&v"(hi[ks]) : "v"(vb), "i"(d0 * 4096 + ks * 1024 + 512) : "memory"); }
        asm volatile("s_waitcnt lgkmcnt(0)" ::: "memory"); SBAR();
#define PK(k) (bf16x8){lo[k][0], lo[k][1], lo[k][2], lo[k][3], hi[k][0], hi[k][1], hi[k][2], hi[k][3]}
        o[d0] = __builtin_amdgcn_mfma_f32_32x32x16_bf16(pa0, PK(0), o[d0], 0, 0, 0);
        o[d0] = __builtin_amdgcn_mfma_f32_32x32x16_bf16(pa1, PK(1), o[d0], 0, 0, 0);
        o[d0] = __builtin_amdgcn_mfma_f32_32x32x16_bf16(pa2, PK(2), o[d0], 0, 0, 0);
        o[d0] = __builtin_amdgcn_mfma_f32_32x32x16_bf16(pa3, PK(3), o[d0], 0, 0, 0);
#undef PK
    }
}
__device__ __forceinline__ void split3(float x, unsigned& b0, unsigned& b1, unsigned& b2) {
    b0 = cvtpk_s(x, 0.f) & 0xffffu; const float r1 = x - __uint_as_float(b0 << 16);
    b1 = cvtpk_s(r1, 0.f) & 0xffffu; const float r2 = r1 - __uint_as_float(b1 << 16);
    b2 = cvtpk_s(r2, 0.f) & 0xffffu;
}
__device__ __forceinline__ bf16x8 make_qx(float m, int hi) {
    unsigned b0, b1, b2; split3(m, b0, b1, b2);
    u32x4 w = (u32x4){0x3F803F80u, 0x3F80u | (b0 << 16), b1 | (b2 << 16), 0u};
    if (hi) w = (u32x4){0u, 0u, 0u, 0u};
    return __builtin_bit_cast(bf16x8, w);
}

template <int THRL> __device__ __forceinline__ void attn_unit(int b, int h, int qb, const bf16* Q, const bf16* __restrict__ K, const bf16* __restrict__ V, bf16* O, char* shm, bool first, int qb_next, bf16x8& qn0, bf16x8& qn1, bf16x8& qn2, bf16x8& qn3) {
    int tid_ = threadIdx.x; asm volatile("" : "+v"(tid_));
    const int tid = tid_, lane = tid & 63, r32 = lane & 31, hi = lane >> 5; const int wid = __builtin_amdgcn_readfirstlane(tid >> 6);
    const long rowbase = (long)b * SEQ; const int q0 = qb * QB;
    const bf16* Qw = Q + (rowbase + q0 + wid * QBLK) * KP + h * D;
    const bf16 *Kh = K + rowbase * KP + h * D, *Vh = V + rowbase * KP + h * D;
    const unsigned lds0 = (unsigned)(uintptr_t)shm;
    float* wsf = (float*)(shm + LDS_WS) + wid * 64;
    const bf16* ksrc = Kh + (long)lane * KP + wid * 8;
    const bf16* vsrc = Vh + (long)(16 * (wid & 3) + (lane >> 2)) * KP + (wid >> 2) * 32 + (lane & 3) * 8;
    const unsigned kdst = lds0 + LDS_K + wid * 1024, vdst = lds0 + LDS_V + wid * 1024;
#define DMA_K(t, slot) glds16(ksrc + (long)(t) * KVBLK * KP, (unsigned)__builtin_amdgcn_readfirstlane(kdst + (slot)))
#define DMA_V(t, slot) glds16(vsrc + (long)(t) * KVBLK * KP, (unsigned)__builtin_amdgcn_readfirstlane(vdst + (slot)))
    const int vb0 = (int)(lds0 + LDS_V) + ((lane >> 4) & 1) * 32 + (lane & 3) * 8 + (4 * hi + ((lane & 15) >> 2)) * 64;
    const char* Kbase = shm + LDS_K; bf16x8 kf[8];
    const lds_cptr shm3 = (lds_cptr)shm; const lds_cptr kxp = hi ? (shm3 + LDS_KX + SEQ * 16) : (shm3 + LDS_KX + r32 * 16); const int kxstep = hi ? 0 : 1024, kxoff2 = hi ? 0 : 512;
    bf16x8 kx[2];
#define KXRD(tt) do { const lds_cptr p_ = kxp + (tt) * kxstep; kx[0] = *(L3BF8*)(p_); kx[1] = *(L3BF8*)(p_ + kxoff2); } while (0)
    const lds_cptr kp0 = shm3 + LDS_K + hi * 1024 + r32 * 16; const lds_cptr vp0 = shm3 + LDS_V + ((lane >> 4) & 1) * 32 + (lane & 3) * 8 + (4 * hi + ((lane & 15) >> 2)) * 64;
    const int NT = (q0 + QB) / KVBLK;
    if (first) { DMA_K(0, 0); DMA_V(0, 0); DMA_K(1, SLOTB); } else { DMA_V(0, 0); }
    bf16x8 qr[4];
    if (first) {
#pragma unroll
        for (int d0 = 0; d0 < 4; ++d0) qr[d0] = *reinterpret_cast<const bf16x8*>(&Qw[(long)r32 * KP + d0 * 16 + hi * 8]);
    } else { qr[0] = qn0; qr[1] = qn1; qr[2] = qn2; qr[3] = qn3; }
    const int qrel = wid * QBLK + r32;
    float mhat = 0.f, l_reg = 0.f; f32x16 o[2]; o[0] = f32x16{}; o[1] = f32x16{}; const f32x16 negm = f32x16{}; bf16x8 qx = make_qx(0.f, hi);
#define CMASK(P0, P1, t) do { int jb_ = (t) - (NT - 4); if (jb_ >= 0) cmask(P0, P1, jb_, qrel, hi); } while (0)
    bool resc = false;
#define START(P0, P1) do { const float rm = rowmax(P0, P1); resc = false; \
    { const float dl = rm; mhat = fadd_s(mhat, dl); \
      _Pragma("unroll") for (int r = 0; r < 16; ++r) { P0[r] = fsub_s(P0[r], dl); P1[r] = fsub_s(P1[r], dl); } \
      qx = make_qx(-mhat, hi); } \
    _Pragma("unroll") for (int r = 0; r < 16; ++r) P0[r] = __builtin_amdgcn_exp2f(P0[r]); } while (0)
#define RESC() do { if (resc) { asm volatile("s_waitcnt lgkmcnt(0)" ::: "memory"); \
      _Pragma("unroll") for (int d_ = 0; d_ < 2; ++d_) _Pragma("unroll") for (int r = 0; r < 16; ++r) o[d_][r] *= wsf[crow(r, hi)]; } } while (0)
    f32x16 pA0, pA1, pB0, pB1;
    int sl_prev = 0, sl_cur = 0, sl_next = SLOTB;
#define ROT() do { sl_prev = sl_cur; sl_cur = sl_next; sl_next = (sl_next == (NSLOT - 1) * SLOTB) ? 0 : sl_next + SLOTB; } while (0)
    if (first) { DMA_K(2, 2 * SLOTB); WAIT_BAR(3); }
    else { WAIT_BAR(1); }
    KXRD(0);
    qkt(pA0, pA1, Kbase, qr, negm, r32, hi, kx[0], kx[1], qx); asm volatile("s_nop 15\n\ts_nop 7" : "+v"(pA0), "+v"(pA1)); CMASK(pA0, pA1, 0);
    START(pA0, pA1);
    _Pragma("unroll") for (int r = 0; r < 16; ++r) pA1[r] = __builtin_amdgcn_exp2f(pA1[r]);
    WAIT_BAR(0);
    DMA_K(3, 0); DMA_V(1, SLOTB);
    ROT();
    kload8(kf, kp0 + sl_cur); KXRD(1);
    WAIT_BAR(2);
    s16x4 vlo[8], vhi[8]; u32x4 pw0, pw1, pw2, pw3;
#define PKW(P, B) cvtpk_s(P[B], P[B + 1])
#define PAF(k) __builtin_bit_cast(bf16x8, pw##k)
#define VFR(i) (bf16x8){vlo[i][0], vlo[i][1], vlo[i][2], vlo[i][3], vhi[i][0], vhi[i][1], vhi[i][2], vhi[i][3]}
#define PIN(x) asm volatile("" : "+v"(x))
#define MX3(a, b, c) __builtin_fmaxf(__builtin_fmaxf((a), (b)), (c))
#define GAPA(MF, A0, A1, A2, A3, W0, W1, PW) do { MF; sacc += A0; sacc += A1; sacc += A2; sacc += A3; PIN(sacc); W0; W1; PIN(PW); SBAR(); } while (0)
#define EX(v) __builtin_amdgcn_exp2f(v)
#define GAPB(MF, X, B) do { MF; X[B] = EX(X[B]); X[B + 1] = EX(X[B + 1]); X[B + 2] = EX(X[B + 2]); X[B + 3] = EX(X[B + 3]); PIN(X); SBAR(); } while (0)
#define VRD(i) do { vlo[i] = vtr(vp_ + (((i) >> 2) * 4096 + ((i) & 3) * 1024)); vhi[i] = vtr(vp_ + (((i) >> 2) * 4096 + ((i) & 3) * 1024 + 512)); } while (0)
#define KRD(G, j) do { if (G) { kload2(kf, kp0 + sl_next, j); SBAR(); } } while (0)
#define STEP(C0, C1, P0, P1, t, GK, GV, GL) do { SBAR(); \
    const lds_cptr vp_ = vp0 + sl_prev; \
    VRD(0); SBAR(); float sacc = (P0[0] + P0[1]); \
    GAPA(C0 = __builtin_amdgcn_mfma_f32_32x32x16_bf16(kf[0], qr[0], negm, 0, 0, 0), P0[2], P0[3], P0[4], P0[5],     pw0[0] = PKW(P0, 0), pw0[1] = PKW(P0, 2), pw0); \
    VRD(4); SBAR(); GAPA(C1 = __builtin_amdgcn_mfma_f32_32x32x16_bf16(kf[1], qr[0], negm, 0, 0, 0), P0[6], P0[7], P0[8], P0[9],     pw0[2] = PKW(P0, 4), pw0[3] = PKW(P0, 6), pw0); \
    VRD(1); SBAR(); GAPA(C0 = __builtin_amdgcn_mfma_f32_32x32x16_bf16(kf[2], qr[1], C0, 0, 0, 0),   P0[10], P0[11], P0[12], P0[13], pw1[0] = PKW(P0, 8), pw1[1] = PKW(P0, 10), pw1); \
    VRD(5); SBAR(); GAPA(C1 = __builtin_amdgcn_mfma_f32_32x32x16_bf16(kf[3], qr[1], C1, 0, 0, 0),   P0[14], P0[15], P1[0], P1[1],   pw1[2] = PKW(P0, 12), pw1[3] = PKW(P0, 14), pw1); \
    VRD(2); SBAR(); GAPA(C0 = __builtin_amdgcn_mfma_f32_32x32x16_bf16(kf[4], qr[2], C0, 0, 0, 0),   P1[2], P1[3], P1[4], P1[5],     pw2[0] = PKW(P1, 0), pw2[1] = PKW(P1, 2), pw2); \
    VRD(6); SBAR(); GAPA(C1 = __builtin_amdgcn_mfma_f32_32x32x16_bf16(kf[5], qr[2], C1, 0, 0, 0),   P1[6], P1[7], P1[8], P1[9],     pw2[2] = PKW(P1, 4), pw2[3] = PKW(P1, 6), pw2); \
    VRD(3); SBAR(); GAPA(C0 = __builtin_amdgcn_mfma_f32_32x32x16_bf16(kf[6], qr[3], C0, 0, 0, 0),   P1[10], P1[11], P1[12], P1[13], pw3[0] = PKW(P1, 8), pw3[1] = PKW(P1, 10), pw3); \
    VRD(7); SBAR(); GAPA(C1 = __builtin_amdgcn_mfma_f32_32x32x16_bf16(kf[7], qr[3], C1, 0, 0, 0),   P1[14], P1[15], 0.f, 0.f,       pw3[2] = PKW(P1, 12), pw3[3] = PKW(P1, 14), pw3); \
    C0 = __builtin_amdgcn_mfma_f32_32x32x16_bf16(kx[0], qx, C0, 0, 0, 0); C1 = __builtin_amdgcn_mfma_f32_32x32x16_bf16(kx[1], qx, C1, 0, 0, 0); \
    l_reg += sacc; \
    if (GK) { DMA_K((t) + 3, sl_cur); } if (GV) { DMA_V((t) + 1, sl_next); } \
    CMASK(C0, C1, t); \
    { float a = MX3(C0[0], C0[1], C1[0]), b = MX3(C0[2], C0[3], C1[1]); a = MX3(a, C1[2], C1[3]); \
      _Pragma("unroll") for (int r = 4; r < 16; r += 4) { a = MX3(a, C0[r], C0[r + 1]); b = MX3(b, C0[r + 2], C0[r + 3]); a = MX3(a, C1[r], C1[r + 1]); b = MX3(b, C1[r + 2], C1[r + 3]); } \
      float rm = __builtin_fmaxf(a, b); { auto rr = __builtin_amdgcn_permlane32_swap(__float_as_uint(rm), __float_as_uint(rm), false, false); rm = __builtin_fmaxf(__uint_as_float(rr[0]), __uint_as_float(rr[1])); } \
      resc = false; \
      if (__builtin_expect(__any(rm > (float)THRL), 0)) { const float dl = __builtin_fmaxf(rm, 0.f); mhat += dl; \
        _Pragma("unroll") for (int r = 0; r < 16; ++r) { C0[r] -= dl; C1[r] -= dl; } \
        qx = make_qx(-mhat, hi); \
        const float f = __builtin_amdgcn_exp2f(-dl); l_reg *= f; if (hi == 0) wsf[r32] = f; resc = true; } } \
    SBAR(); \
    GAPB(o[0] = __builtin_amdgcn_mfma_f32_32x32x16_bf16(PAF(0), VFR(0), o[0], 0, 0, 0), C0, 0); \
    GAPB(o[1] = __builtin_amdgcn_mfma_f32_32x32x16_bf16(PAF(0), VFR(4), o[1], 0, 0, 0), C0, 4); \
    KRD(GL, 0); if (GL) { KXRD((t) + 1); SBAR(); } GAPB(o[0] = __builtin_amdgcn_mfma_f32_32x32x16_bf16(PAF(1), VFR(1), o[0], 0, 0, 0), C0, 8); \
    KRD(GL, 1); GAPB(o[1] = __builtin_amdgcn_mfma_f32_32x32x16_bf16(PAF(1), VFR(5), o[1], 0, 0, 0), C0, 12); \
    KRD(GL, 2); GAPB(o[0] = __builtin_amdgcn_mfma_f32_32x32x16_bf16(PAF(2), VFR(2), o[0], 0, 0, 0), C1, 0); \
    KRD(GL, 3); GAPB(o[1] = __builtin_amdgcn_mfma_f32_32x32x16_bf16(PAF(2), VFR(6), o[1], 0, 0, 0), C1, 4); \
    GAPB(o[0] = __builtin_amdgcn_mfma_f32_32x32x16_bf16(PAF(3), VFR(3), o[0], 0, 0, 0), C1, 8); \
    GAPB(o[1] = __builtin_amdgcn_mfma_f32_32x32x16_bf16(PAF(3), VFR(7), o[1], 0, 0, 0), C1, 12); \
    } while (0)
    int t = 1;
#undef CMASK
#define CMASK(P0, P1, t) do { } while (0)
    for (; t + 5 < NT; t += 2) {
        STEP(pB0, pB1, pA0, pA1, t, true, true, true);     WAIT_BAR(2); RESC(); ROT();
        STEP(pA0, pA1, pB0, pB1, t + 1, true, true, true); WAIT_BAR(2); RESC(); ROT();
    }
#undef CMASK
#define CMASK(P0, P1, t) do { int jb_ = (t) - (NT - 4); if (jb_ >= 0) cmask(P0, P1, jb_, qrel, hi); } while (0)
#define ENDW(tt) do { if ((tt) + 3 < NT) { WAIT_BAR(2); } else if ((tt) + 2 < NT) { WAIT_BAR(1); } else { WAIT_BAR(0); } } while (0)
    for (; t + 1 < NT; t += 2) {
        STEP(pB0, pB1, pA0, pA1, t, (t + 3 < NT), (t + 1 < NT), (t + 1 < NT));         ENDW(t);     RESC(); ROT();
        STEP(pA0, pA1, pB0, pB1, t + 1, (t + 4 < NT), (t + 2 < NT), (t + 2 < NT));     ENDW(t + 1); RESC(); ROT();
    }
    if (qb_next >= 0) { DMA_K(0, 0); DMA_K(1, SLOTB); DMA_K(2, 2 * SLOTB); }
    STEP(pB0, pB1, pA0, pA1, NT - 1, false, false, false); RESC();
    { float sacc = pB0[0] + pB0[1]; _Pragma("unroll") for (int r = 2; r < 16; ++r) sacc += pB0[r]; _Pragma("unroll") for (int r = 0; r < 16; ++r) sacc += pB1[r]; l_reg += sacc;
      pw0 = (u32x4){PKW(pB0, 0), PKW(pB0, 2), PKW(pB0, 4), PKW(pB0, 6)}; pw1 = (u32x4){PKW(pB0, 8), PKW(pB0, 10), PKW(pB0, 12), PKW(pB0, 14)}; pw2 = (u32x4){PKW(pB1, 0), PKW(pB1, 2), PKW(pB1, 4), PKW(pB1, 6)}; pw3 = (u32x4){PKW(pB1, 8), PKW(pB1, 10), PKW(pB1, 12), PKW(pB1, 14)};
      SBAR(); pv(o, vb0 + sl_cur, PAF(0), PAF(1), PAF(2), PAF(3)); }
    if (qb_next >= 0) { const bf16* Qn = Q + (rowbase + qb_next * QB + wid * QBLK) * KP + h * D;
        qn0 = *reinterpret_cast<const bf16x8*>(&Qn[(long)r32 * KP + 0 * 16 + hi * 8]); qn1 = *reinterpret_cast<const bf16x8*>(&Qn[(long)r32 * KP + 1 * 16 + hi * 8]);
        qn2 = *reinterpret_cast<const bf16x8*>(&Qn[(long)r32 * KP + 2 * 16 + hi * 8]); qn3 = *reinterpret_cast<const bf16x8*>(&Qn[(long)r32 * KP + 3 * 16 + hi * 8]); }
#undef PKW
#undef PAF
#undef VFR
#undef PIN
#undef MX3
#undef GAPA
#undef GAPB
#undef EX
#undef VRD
#undef KRD
#undef STEP
#undef ENDW
    { auto rr = __builtin_amdgcn_permlane32_swap(__float_as_uint(l_reg), __float_as_uint(l_reg), false, false); l_reg = __uint_as_float(rr[0]) + __uint_as_float(rr[1]); }
    if (hi == 0) wsf[32 + r32] = l_reg; asm volatile("s_waitcnt lgkmcnt(0)" ::: "memory");
    float rli[16];
#pragma unroll
    for (int r = 0; r < 16; ++r) rli[r] = __builtin_amdgcn_rcpf(wsf[32 + crow(r, hi)]);
    bf16* Ow = O + (rowbase + q0 + wid * QBLK) * OP + h * D;
    { bf16* stg = (bf16*)(shm + LDS_OST) + wid * 2048;
#pragma unroll
      for (int r = 0; r < 16; ++r) { const int orow = crow(r, hi);
#pragma unroll
          for (int d0 = 0; d0 < 2; ++d0) stg[orow * 64 + d0 * 32 + r32] = __float2bfloat16(o[d0][r] * rli[r]); }
      asm volatile("s_waitcnt lgkmcnt(0)" ::: "memory");
#pragma unroll
      for (int i = 0; i < 4; ++i) { const int row = i * 8 + (lane >> 3), ch = lane & 7; const u32x4 v = *(const u32x4*)(stg + row * 64 + ch * 8); *(u32x4*)(Ow + (long)row * OP + ch * 8) = v; } }
    asm volatile("s_waitcnt lgkmcnt(0)\n\ts_barrier" ::: "memory");
#undef DMA_K
#undef DMA_V
#undef KXRD
#undef CMASK
#undef START
#undef RESC
#undef ROT
}
#undef SBAR
#undef WAIT_BAR
}

#define LAS __attribute__((address_space(3)))
typedef unsigned short bf16;
typedef unsigned v4u __attribute__((ext_vector_type(4)));
typedef unsigned v2u __attribute__((ext_vector_type(2)));
typedef float f32x4 __attribute__((ext_vector_type(4)));
typedef float f32x2 __attribute__((ext_vector_type(2)));
#ifndef REP_0
#define REP_0 1
#endif
#ifndef REP_3
#define REP_3 1
#endif
#ifndef REP_4
#define REP_4 1
#endif
#ifndef REP_5
#define REP_5 1
#endif
#ifndef REP_6
#define REP_6 1
#endif
#ifndef REP_8
#define REP_8 1
#endif
#ifndef REP_9
#define REP_9 1
#endif
#ifndef REPA
#define REPA 1
#endif
#ifndef REP_1
#define REP_1 1
#endif
#ifndef REP_X
#define REP_X 1
#endif
#ifndef XSYNC
#define XSYNC 0
#endif
#ifndef REPC
#define REPC 1
#endif
#ifndef REP2
#define REP2 1
#endif
#ifndef ONLY
#define ONLY -1
#endif
#define PH(n) if (ONLY < 0 || ONLY == (n))
#ifndef CGFIRST
#define CGFIRST 0
#endif
constexpr int NWAVES = 8;
constexpr size_t MiB = 1u << 20;
constexpr size_t WS_WIN = 0, WS_WOUT = 5 * MiB, WS_WMQ = 7 * MiB, WS_WMKV = 9 * MiB, WS_WMO = 13 * MiB, WS_WGU = 15 * MiB, WS_WDN = 26 * MiB;
constexpr size_t WS_LOGF = 32 * MiB, WS_SS1 = 34 * MiB, WS_SS2 = 36 * MiB, WS_MEMN = 38 * MiB, WS_KVM = 46 * MiB;
constexpr size_t WS_BAR = 62 * MiB;  constexpr size_t WS_CNT = 62 * MiB + 32768, WS_SS3 = 62 * MiB + 65536;
constexpr size_t WS_XN = 64 * MiB;
constexpr size_t WS_Z = 128 * MiB;
constexpr size_t WS_QM = 128 * MiB, WS_P = 192 * MiB, WS_OM = 256 * MiB, WS_HMID = 128 * MiB;
constexpr size_t WS_CAT = 320 * MiB;
constexpr size_t WS_WMQ2 = 448 * MiB, WS_WMO2 = 452 * MiB;
constexpr size_t WS_WK = 384 * MiB, WS_VW = 416 * MiB;
constexpr size_t WS_END = 512 * MiB;
constexpr int RING_BYTES = 131072, XL_OFF = RING_BYTES, BARST_OFF = XL_OFF + 8192, LDS_BYTES = 147456;

struct Args { const float* in[19]; float* out; unsigned char* ws; };

__device__ __forceinline__ float wave_sum(float v) {
#pragma unroll
    for (int o = 1; o < 64; o <<= 1) v += __shfl_xor(v, o);
    return v;
}
__device__ __forceinline__ unsigned pk2(float lo, float hi) { return pg8::cvt_pk_bf16(lo, hi); }
__device__ __forceinline__ float bflo(unsigned w) { return __uint_as_float(w << 16); }
__device__ __forceinline__ float bfhi(unsigned w) { return __uint_as_float(w & 0xffff0000u); }

__device__ __forceinline__ void transpose_item(const float* W, int ldw, int K, const float* gain, bf16* WT, int kb, int scol0, int drow0, LAS float* scr, int lane) {
    const int k0 = 64 * kb;
#pragma unroll 4
    for (int i = 0; i < 16; ++i) { const int kk = 4 * i + (lane >> 4); f32x4 w = *(const f32x4*)(W + (size_t)(k0 + kk) * ldw + scol0 + 4 * (lane & 15)); if (gain) w = w * gain[k0 + kk];
        LAS float* d = scr + kk * 65 + 4 * (lane & 15); d[0] = w[0]; d[1] = w[1]; d[2] = w[2]; d[3] = w[3]; }
    asm volatile("s_waitcnt lgkmcnt(0)" ::: "memory");
    const int c = lane & 7;
#pragma unroll
    for (int j = 0; j < 8; ++j) { const int n = (lane >> 3) + 8 * j; const LAS float* p = scr + (8 * c) * 65 + n;
        v4u o; o.x = pk2(p[0 * 65], p[1 * 65]); o.y = pk2(p[2 * 65], p[3 * 65]); o.z = pk2(p[4 * 65], p[5 * 65]); o.w = pk2(p[6 * 65], p[7 * 65]);
        *(v4u*)(WT + (size_t)(drow0 + n) * K + k0 + 8 * c) = o; }
    asm volatile("s_waitcnt lgkmcnt(0)" ::: "memory");
}

#define XB_TMO      128
#define XB_XCNT(j)  (256  + 64 * (j))
#define XB_XSUB(j)  (1280 + 64 * (j))
#define XB_XGEN(j)  (2304 + 64 * (j))
#define XB_TOP      3328
#define XB_TOPGEN   3392
#define XCD_BAR_WORDS 3456
#define XB_SPIN_CAP (1u << 22)
__device__ __forceinline__ unsigned xb_ld(unsigned* p)              { return __hip_atomic_load(p, __ATOMIC_RELAXED, __HIP_MEMORY_SCOPE_AGENT); }
__device__ __forceinline__ unsigned xb_add(unsigned* p, unsigned v) { return __hip_atomic_fetch_add(p, v, __ATOMIC_RELAXED, __HIP_MEMORY_SCOPE_AGENT); }
__device__ __forceinline__ unsigned xb_xcc_id() { return (unsigned)__builtin_amdgcn_s_getreg((3 << 11) | 20) & 0xFu; }
#define XB_SPIN(cond, bar) do { unsigned _sp = 0; while (cond) { __builtin_amdgcn_s_sleep(1); \
    if ((++_sp & 255u) == 0u) { if (xb_ld(&(bar)[XB_TMO])) break; if (_sp > XB_SPIN_CAP) { atomicAdd(&(bar)[XB_TMO], 1u); break; } } } } while (0)
struct XcdBarrier { unsigned* bar; unsigned x; volatile LAS unsigned* st; };
__device__ __forceinline__ XcdBarrier xcd_barrier_post(unsigned* bar, volatile LAS unsigned* st) {
    XcdBarrier b; b.bar = bar; b.x = xb_xcc_id(); b.st = st;
    if (threadIdx.x == 0) (void)xb_add(&bar[XB_XCNT(b.x)], 1u);
    return b;
}
__device__ __forceinline__ void xcd_barrier_complete(unsigned* bar, unsigned x, unsigned& nloc, unsigned& nx) {
    const unsigned G = gridDim.x * gridDim.y * gridDim.z;
    unsigned sum, cnt, mine, sp = 0u;
    for (;;) {
        sum = 0u; cnt = 0u; mine = 0u;
#pragma unroll
        for (unsigned j = 0; j < 16; ++j) { const unsigned c = xb_ld(&bar[XB_XCNT(j)]); sum += c; cnt += (c > 0u) ? 1u : 0u; mine = (j == x) ? c : mine; }
        if (sum == G) break;
        __builtin_amdgcn_s_sleep(1);
        if ((++sp & 255u) == 0u) { if (xb_ld(&bar[XB_TMO])) break; if (sp > XB_SPIN_CAP) { atomicAdd(&bar[XB_TMO], 1u); break; } }
    }
    nloc = mine > 0u ? mine : 1u; nx = cnt > 0u ? cnt : 1u;
}
__device__ __forceinline__ void xcd_barrier(const XcdBarrier& b) {
    asm volatile("s_waitcnt vmcnt(0)" ::: "memory");
    __syncthreads();
    if (threadIdx.x == 0) {
        unsigned* bar = b.bar;
        __builtin_amdgcn_s_waitcnt(0);
        unsigned nloc = b.st[0], nx = b.st[1];
        if (nloc == 0u) { xcd_barrier_complete(bar, b.x, nloc, nx); b.st[0] = nloc; b.st[1] = nx; }
        const unsigned old = xb_add(&bar[XB_XSUB(b.x)], 1u);
        const unsigned gen = old / nloc;
        if (old + 1u == (gen + 1u) * nloc) {
            __builtin_amdgcn_fence(__ATOMIC_RELEASE, "agent");
            asm volatile("s_waitcnt vmcnt(0)" ::: "memory");
            const unsigned og = xb_add(&bar[XB_TOP], 1u);
            const unsigned tg = og / nx;
            if (og + 1u == (tg + 1u) * nx) xb_add(&bar[XB_TOPGEN], 1u);
            else XB_SPIN(xb_ld(&bar[XB_TOPGEN]) == tg, bar);
            __builtin_amdgcn_fence(__ATOMIC_ACQUIRE, "agent");
            xb_add(&bar[XB_XGEN(b.x)], 1u);
            asm volatile("s_waitcnt vmcnt(0)" ::: "memory");
        } else {
            XB_SPIN(xb_ld(&bar[XB_XGEN(b.x)]) == gen, bar);
            __builtin_amdgcn_fence(__ATOMIC_ACQUIRE, "agent");
            asm volatile("s_waitcnt vmcnt(0)" ::: "memory");
        }
    }
    __syncthreads();
}

#define XL_SUB(j)  (4096 + 64 * (j))
#define XL_GEN(j)  (5120 + 64 * (j))
#define XL_BAD     6144
__device__ __forceinline__ void xcd_local_barrier(const XcdBarrier& b) {
    asm volatile("s_waitcnt vmcnt(0)" ::: "memory");
    __syncthreads();
    if (threadIdx.x == 0) {
        unsigned* bar = b.bar; const unsigned nloc = b.st[0];
        const unsigned old = xb_add(&bar[XL_SUB(b.x)], 1u); const unsigned gen = old / nloc;
        if (old + 1u == (gen + 1u) * nloc) xb_add(&bar[XL_GEN(b.x)], 1u);
        else XB_SPIN(xb_ld(&bar[XL_GEN(b.x)]) == gen, bar);
        __builtin_amdgcn_fence(__ATOMIC_ACQUIRE, "agent");
        asm volatile("s_waitcnt vmcnt(0)" ::: "memory");
    }
    __syncthreads();
}

__global__ void __launch_bounds__(NWAVES * 64, 2) mk_fwd(Args args) {
    extern __shared__ __attribute__((aligned(16))) unsigned char lds_raw[];
    cg::grid_group grid = cg::this_grid();
    LAS unsigned char* lds = (LAS unsigned char*)lds_raw;
    LAS unsigned char* xl = lds + XL_OFF;
#define KARG(i) ({ unsigned long long p_; asm volatile("s_load_dwordx2 %0, %1, %2\n\ts_waitcnt lgkmcnt(0)" : "=s"(p_) : "s"((unsigned long long)__builtin_amdgcn_kernarg_segment_ptr()), "n"((i) * 8)); p_; })
#define IN(i) ((const float*)KARG(i))
#define WSB(off) ((bf16*)((unsigned char*)KARG(20) + (off)))
#define WSF(off) ((float*)((unsigned char*)KARG(20) + (off)))
#define OUTP ((float*)KARG(19))
    if (threadIdx.x < 2) ((volatile LAS unsigned*)(lds + BARST_OFF))[threadIdx.x] = 0u;
    __syncthreads();
    XcdBarrier xbar; xbar.bar = (unsigned*)((unsigned char*)KARG(20) + WS_BAR); xbar.x = 0; xbar.st = (volatile LAS unsigned*)(lds + BARST_OFF);
    if (!CGFIRST) xbar = xcd_barrier_post((unsigned*)((unsigned char*)KARG(20) + WS_BAR), (volatile LAS unsigned*)(lds + BARST_OFF));
    if (!CGFIRST && threadIdx.x == 0 && xbar.x != (blockIdx.x & 7u)) (void)xb_add(&xbar.bar[XL_BAD], 1u);
#define GSYNC() xcd_barrier(xbar)
    if (!CGFIRST && gridDim.y == 4242u) grid.sync();
#define PHASE_VARS int t__ = threadIdx.x; asm volatile("" : "+v"(t__)); int b__ = blockIdx.x; asm volatile("" : "+s"(b__)); \
    const int tid = t__, lane = tid & 63, wave = __builtin_amdgcn_readfirstlane(tid >> 6); const int G = gridDim.x, bx = b__; \
    const int vcu = (G % 8 == 0) ? (bx % 8) * (G / 8) + bx / 8 : bx; const int gw = vcu * NWAVES + wave, NGW = G * NWAVES; (void)tid; (void)lane; (void)gw; (void)NGW; (void)vcu; (void)bx;

    for (int rp = 0; rp < REP_0; ++rp) { if (rp) grid.sync();
    PH(0) { PHASE_VARS
        if (CGFIRST && bx == 0) { unsigned* bw = (unsigned*)((unsigned char*)KARG(20) + WS_BAR); for (int i = tid; i < 16384; i += NWAVES * 64) __hip_atomic_store(bw + i, 0u, __ATOMIC_RELAXED, __HIP_MEMORY_SCOPE_AGENT); }
        const float* x = IN(0); const float* mem = IN(1); const float* g_mix = IN(2); const float* w_in = IN(3); const float* b_f = IN(4); const float* g_mem = IN(11);
        bf16* XN = WSB(WS_XN); bf16* MEMN = WSB(WS_MEMN); float* LOGF = WSF(WS_LOGF);
        LAS float* scr = (LAS float*)(lds + wave * 16640);
        constexpr int I_IN = 16 * 40, I_MKV = 16 * 32;
        for (int it = gw; it < I_IN + I_MKV; it += NGW) {
            int r = it;
            if (r < I_IN) { const int kb = r / 40, nb = r % 40; const int sc = 64 * nb; int dr = sc;
                if (sc < 1024) { const int i0 = sc < 512 ? sc : sc - 512; dr = 256 * (i0 / 128) + (i0 % 128) + (sc < 512 ? 0 : 128); }
                transpose_item(w_in, DIN, 1024, nullptr, WSB(WS_WIN), kb, sc, dr, scr, lane); continue; } r -= I_IN;
            { const int kb = r / 32, nb = r % 32; transpose_item(IN(13), 2048, 1024, nullptr, WSB(WS_WMKV), kb, 64 * nb, 64 * nb, scr, lane); }
        }
        __syncthreads();
        LAS float* wfT = (LAS float*)lds;
        for (int i = tid; i < 8192; i += NWAVES * 64) { const int k = i >> 3, h = i & 7; wfT[h * 1024 + k] = w_in[(size_t)k * DIN + 2560 + h]; }
        __syncthreads();
        f32x4 wfr[8][4];
#pragma unroll
        for (int h = 0; h < 8; ++h)
#pragma unroll
            for (int j = 0; j < 4; ++j) wfr[h][j] = *(const LAS f32x4*)(wfT + h * 1024 + 256 * j + 4 * lane);
        f32x4 gg[4];
#pragma unroll
        for (int j = 0; j < 4; ++j) gg[j] = ((const f32x4*)g_mix)[64 * j + lane];
        const int hsel = ((lane >> 5) & 1) * 4 + ((lane >> 4) & 1) * 2 + ((lane >> 3) & 1);
        const float bfl = b_f[hsel];
        {
            f32x4 cur[4], nxt[4];
            int m = gw;
            if (m < T) { const f32x4* xr = (const f32x4*)(x + (size_t)m * DM) + lane;
#pragma unroll
                for (int j = 0; j < 4; ++j) cur[j] = xr[64 * j]; }
#pragma unroll 1
            for (; m < T; m += NGW) {
                const int mn = m + NGW;
                if (mn < T) { const f32x4* xr = (const f32x4*)(x + (size_t)mn * DM) + lane;
#pragma unroll
                    for (int j = 0; j < 4; ++j) nxt[j] = xr[64 * j]; }
                float s = 0.f;
#pragma unroll
                for (int j = 0; j < 4; ++j) s += (cur[j][0] * cur[j][0] + cur[j][1] * cur[j][1]) + (cur[j][2] * cur[j][2] + cur[j][3] * cur[j][3]);
                float z[8];
#pragma unroll
                for (int h = 0; h < 8; ++h) z[h] = 0.f;
#pragma unroll
                for (int j = 0; j < 4; ++j) { cur[j] = cur[j] * gg[j];
#pragma unroll
                    for (int h = 0; h < 8; ++h) z[h] += (cur[j][0] * wfr[h][j][0] + cur[j][1] * wfr[h][j][1]) + (cur[j][2] * wfr[h][j][2] + cur[j][3] * wfr[h][j][3]); }
                const float rs = 1.0f / sqrtf(wave_sum(s) * (1.f / DM) + EPS);
                unsigned long long* o8 = (unsigned long long*)(XN + (size_t)m * DM) + lane;
#pragma unroll
                for (int j = 0; j < 4; ++j) { const f32x4 v = cur[j] * rs; o8[64 * j] = (unsigned long long)pk2(v[0], v[1]) | ((unsigned long long)pk2(v[2], v[3]) << 32); }
                float s4[4], s2[2], s1;
#pragma unroll
                for (int i = 0; i < 4; ++i) { const float send = (lane & 32) ? z[i] : z[4 + i], keep = (lane & 32) ? z[4 + i] : z[i]; s4[i] = keep + __shfl_xor(send, 32); }
#pragma unroll
                for (int i = 0; i < 2; ++i) { const float send = (lane & 16) ? s4[i] : s4[2 + i], keep = (lane & 16) ? s4[2 + i] : s4[i]; s2[i] = keep + __shfl_xor(send, 16); }
                { const float send = (lane & 8) ? s2[0] : s2[1], keep = (lane & 8) ? s2[1] : s2[0]; s1 = keep + __shfl_xor(send, 8); }
                s1 += __shfl_xor(s1, 4); s1 += __shfl_xor(s1, 2); s1 += __shfl_xor(s1, 1);
                if ((lane & 7) == 0) { const float zz = s1 * rs + bfl; LOGF[(size_t)m * 8 + hsel] = fminf(zz, 0.f) - log1pf(expf(-fabsf(zz))); }
#pragma unroll
                for (int j = 0; j < 4; ++j) cur[j] = nxt[j];
            }
        }
#pragma unroll
        for (int j = 0; j < 4; ++j) gg[j] = ((const f32x4*)g_mem)[64 * j + lane];
        for (int m = gw; m < NB * ML; m += NGW) {
            const f32x4* xr = (const f32x4*)(mem + (size_t)m * DM) + lane;
            f32x4 v[4]; float s = 0.f;
#pragma unroll
            for (int j = 0; j < 4; ++j) { v[j] = xr[64 * j]; s += (v[j][0] * v[j][0] + v[j][1] * v[j][1]) + (v[j][2] * v[j][2] + v[j][3] * v[j][3]); }
            const float rs = 1.0f / sqrtf(wave_sum(s) * (1.f / DM) + EPS);
            unsigned long long* o8 = (unsigned long long*)(MEMN + (size_t)m * DM) + lane;
#pragma unroll
            for (int j = 0; j < 4; ++j) { v[j] = v[j] * rs * gg[j]; o8[64 * j] = (unsigned long long)pk2(v[j][0], v[j][1]) | ((unsigned long long)pk2(v[j][2], v[j][3]) << 32); }
        }
    } }
    if (CGFIRST) { grid.sync(); xbar = xcd_barrier_post((unsigned*)((unsigned char*)KARG(20) + WS_BAR), (volatile LAS unsigned*)(lds + BARST_OFF)); } else GSYNC();

    PH(1) { PHASE_VARS
        pg8::Gemm g{WSB(WS_XN), WSB(WS_WIN), DM, DM, DM}; pg8::Sched2D S; S.init(T, ZP, G, bx, DM, DM);
        pg8::EpiZ E{WSB(WS_Z), ZP, attn_body::C2};
        for (int rp = 0; rp < REP_1; ++rp) pg8::gemm_phase(lds, xl, g, S, E);
    }
    PH(11) { PHASE_VARS
        pg8::Gemm g{WSB(WS_MEMN), WSB(WS_WMKV), DM, DM, DM}; pg8::Sched2D S; S.init(NB * ML, 2 * DM, G, bx, DM, DM);
        pg8::EpiBf16 E{WSB(WS_KVM), 2 * DM, 0, 0, 1.f};
        pg8::gemm_phase(lds, xl, g, S, E);
    }
    PH(13) { PHASE_VARS
        const int half = G / 2;
        if (bx >= half) {
            LAS float* scr = (LAS float*)(lds + wave * 16640);
            constexpr int I_OUT = 16 * 16, I_MQ = 1024, I_MO = 16 * 16, I_GU = 16 * 88, I_DN = 44 * 16;
            for (int it = (bx - half) * NWAVES + wave; it < I_OUT + I_MQ + I_MO + I_GU + I_DN; it += (G - half) * NWAVES) {
                int r = it;
                if (r < I_OUT) { const int kb = r / 16, nb = r % 16; transpose_item(IN(9), 1024, 1024, nullptr, WSB(WS_WOUT), kb, 64 * nb, 64 * nb, scr, lane); continue; } r -= I_OUT;
                if (r < I_MQ) {
                    const float gk = IN(10)[r]; const f32x4* wr_ = (const f32x4*)(IN(12) + (size_t)r * DM) + lane; unsigned long long* o8 = (unsigned long long*)(WSB(WS_WMQ2) + (size_t)r * 2048) + lane;
#pragma unroll
                    for (int j = 0; j < 4; ++j) { const f32x4 v = wr_[64 * j] * gk; o8[64 * j] = (unsigned long long)pk2(v[0], v[1]) | ((unsigned long long)pk2(v[2], v[3]) << 32); }
                    continue; } r -= I_MQ;
                if (r < I_MO) { const int kb = r / 16, nb = r % 16; transpose_item(IN(14), 1024, 2048, nullptr, WSB(WS_WMO2), kb, 64 * nb, 64 * nb, scr, lane); continue; } r -= I_MO;
                if (r < I_GU) { const int kb = r / 88, nb = r % 88; const int sc = 64 * nb; const int i0 = sc < DFF ? sc : sc - DFF; const int dr = 256 * (i0 / 128) + (i0 % 128) + (sc < DFF ? 0 : 128);
                    transpose_item(IN(16), 2 * DFF, 1024, IN(15), WSB(WS_WGU), kb, sc, dr, scr, lane); continue; } r -= I_GU;
                { const int kb = r / 16, nb = r % 16; transpose_item(IN(17), 1024, DFF, nullptr, WSB(WS_WDN), kb, 64 * nb, 64 * nb, scr, lane); }
            }
        }
    }
    GSYNC();

    const bool xl_ok = !CGFIRST && gridDim.x == 256 && xb_ld(&xbar.bar[XL_BAD]) == 0u;
#define LSYNC() do { if (xl_ok) xcd_local_barrier(xbar); else GSYNC(); } while (0)

    for (int rep2 = 0; rep2 < REP2; ++rep2) {
    if (rep2) GSYNC();
    PH(2) { PHASE_VARS
        const float* LOGF = WSF(WS_LOGF); bf16* Z = WSB(WS_Z); bf16* CAT = WSB(WS_CAT);
        const float* conv_w = IN(5); const float* conv_b = IN(6); const float* ln_g = IN(7); const float* ln_b = IN(8);
        const int NV = G;
        for (int repa = 0; repa < REPA; ++repa)
        for (int v0 = vcu; v0 < 256; v0 += NV) {
            const int bh = v0 >> 1, b = bh >> 3, h = bh & 7, sel = v0 & 1;
            {
                LAS v4u* kxt = (LAS v4u*)(lds + attn_body::LDS_KX);
                LAS float* wtot = (LAS float*)(lds + attn_body::LDS_WS);
                const float* lf = LOGF + ((size_t)b * SEQ + 4 * tid) * 8 + h;
                const float a0 = lf[0], a1 = a0 + lf[8], a2 = a1 + lf[16], a3 = a2 + lf[24];
                float incl = a3;
#pragma unroll
                for (int o = 1; o < 64; o <<= 1) { const float n = __shfl_up(incl, o); if (lane >= o) incl += n; }
                if (lane == 63) wtot[wave] = incl;
                __syncthreads();
                float base = incl - a3;
                for (int w = 0; w < wave; ++w) base += wtot[w];
                const float cc[4] = {-(base + a0) * LOG2E, -(base + a1) * LOG2E, -(base + a2) * LOG2E, -(base + a3) * LOG2E};
#pragma unroll
                for (int j = 0; j < 4; ++j) { unsigned b0, b1, b2; attn_body::split3(cc[j], b0, b1, b2); kxt[4 * tid + j] = (v4u){b0 | (b1 << 16), b2 | (0x3F80u << 16), 0x3F803F80u, 0u}; }
                if (tid == 0) { unsigned zz = 0u; asm volatile("" : "+v"(zz)); kxt[SEQ] = (v4u){zz, zz, zz, zz}; }
                __syncthreads();
            }
            const attn_body::bf16* Zb = (const attn_body::bf16*)Z;
#ifndef NO_ATT
            attn_body::bf16x8 qn0 = {}, qn1 = {}, qn2 = {}, qn3 = {};
#pragma unroll 1
            for (int i = 0; i < 4; ++i) {
#define QB_OF(i_) (sel == 0 ? ((i_) == 0 ? 0 : (i_) == 1 ? 7 : (i_) == 2 ? 1 : 6) : ((i_) == 0 ? 2 : (i_) == 1 ? 5 : (i_) == 2 ? 3 : 4))
                const int qb = QB_OF(i), qbn = (i < 3) ? QB_OF(i + 1) : -1;
                attn_body::attn_unit<96>(b, h, qb, Zb + 1024, Zb + 1536, Zb + 2048, (attn_body::bf16*)CAT + 512, (char*)lds_raw, i == 0, qbn, qn0, qn1, qn2, qn3);
#undef QB_OF
            }
#endif
            __syncthreads();
        }
#ifndef NO_CONV
        {
            const int cp = tid & 255, th = tid >> 8;
            f32x2 w[31];
#pragma unroll
            for (int j = 0; j < 31; ++j) w[j] = *(const f32x2*)(conv_w + j * 512 + 2 * cp);
            const f32x2 cb = *(const f32x2*)(conv_b + 2 * cp);
            LAS float* yt = (LAS float*)lds;
            f32x4 lg0 = *(const f32x4*)(ln_g + 4 * lane), lg1 = *(const f32x4*)(ln_g + 256 + 4 * lane), lb0 = *(const f32x4*)(ln_b + 4 * lane), lb1 = *(const f32x4*)(ln_b + 256 + 4 * lane);
#define GLU2(uu) ((f32x2){bflo(uu), bfhi(uu)})
            for (int repc = 0; repc < REPC; ++repc)
            for (int kt = 0, tile = (G == 256) ? 64 * (vcu >> 5) + (vcu & 31) : vcu; tile < T / 64; ++kt, tile = (G == 256) ? ((kt < 2) ? 64 * (vcu >> 5) + 32 * kt + (vcu & 31) : T) : tile + G) {
                const int R0 = tile * 64, tl0 = R0 % SEQ;
                const bf16* zb = Z + (size_t)(R0 + 32 * th) * ZP + 2 * cp;
                f32x2 win[38]; unsigned ru[8];
#pragma unroll
                for (int i = 0; i < 38; ++i) win[i] = (f32x2){0.f, 0.f};
                if (tl0 + 32 * th > 0) {
#pragma unroll
                    for (int i = 0; i < 30; ++i) { const bf16* zr = zb + (long)(i - 30) * ZP; const unsigned uu = *(const unsigned*)zr; win[8 + i] = GLU2(uu); } }
#pragma unroll
                for (int i = 0; i < 8; ++i) { const bf16* zr = zb + (long)i * ZP; ru[i] = *(const unsigned*)zr; }
#pragma unroll 1
                for (int blk = 0; blk < 4; ++blk) {
                    const int tb = 32 * th + 8 * blk;
#pragma unroll
                    for (int i = 0; i < 30; ++i) win[i] = win[i + 8];
#pragma unroll
                    for (int i = 0; i < 8; ++i) win[30 + i] = GLU2(ru[i]);
                    if (blk < 3) {
#pragma unroll
                        for (int i = 0; i < 8; ++i) { const bf16* zr = zb + (long)(8 * blk + 8 + i) * ZP; ru[i] = *(const unsigned*)zr; } }
#pragma unroll
                    for (int o = 0; o < 8; ++o) { f32x2 y = cb;
#pragma unroll
                        for (int j = 0; j < 31; ++j) y += w[j] * win[o + j];
                        *(LAS f32x2*)(yt + (tb + o) * 512 + 2 * cp) = y; }
                }
                __syncthreads();
                {
                    f32x4 a[8], c[8]; float sm[8];
#pragma unroll
                    for (int k = 0; k < 8; ++k) { const int tok = wave * 8 + k; a[k] = *(const LAS f32x4*)(yt + tok * 512 + 4 * lane); c[k] = *(const LAS f32x4*)(yt + tok * 512 + 256 + 4 * lane);
                        sm[k] = ((a[k][0] + a[k][1]) + (a[k][2] + a[k][3])) + ((c[k][0] + c[k][1]) + (c[k][2] + c[k][3])); }
#pragma unroll
                    for (int o = 1; o < 64; o <<= 1) {
#pragma unroll
                        for (int k = 0; k < 8; ++k) sm[k] += __shfl_xor(sm[k], o); }
#pragma unroll
                    for (int k = 0; k < 8; ++k) { const float mu = sm[k] * (1.f / 512.f); a[k] = a[k] - mu; c[k] = c[k] - mu;
                        sm[k] = ((a[k][0] * a[k][0] + a[k][1] * a[k][1]) + (a[k][2] * a[k][2] + a[k][3] * a[k][3])) + ((c[k][0] * c[k][0] + c[k][1] * c[k][1]) + (c[k][2] * c[k][2] + c[k][3] * c[k][3])); }
#pragma unroll
                    for (int o = 1; o < 64; o <<= 1) {
#pragma unroll
                        for (int k = 0; k < 8; ++k) sm[k] += __shfl_xor(sm[k], o); }
#pragma unroll
                    for (int k = 0; k < 8; ++k) { const int tok = wave * 8 + k; const float rstd = 1.0f / sqrtf(sm[k] * (1.f / 512.f) + EPS);
                        f32x4 x = a[k] * rstd * lg0 + lb0, y = c[k] * rstd * lg1 + lb1;
#pragma unroll
                        for (int e = 0; e < 4; ++e) { x[e] = x[e] * __builtin_amdgcn_rcpf(1.f + __builtin_amdgcn_exp2f(-LOG2E * x[e])); y[e] = y[e] * __builtin_amdgcn_rcpf(1.f + __builtin_amdgcn_exp2f(-LOG2E * y[e])); }
                        bf16* orow = CAT + (size_t)(R0 + tok) * DM;
                        *(v2u*)(orow + 4 * lane) = (v2u){pk2(x[0], x[1]), pk2(x[2], x[3])}; *(v2u*)(orow + 256 + 4 * lane) = (v2u){pk2(y[0], y[1]), pk2(y[2], y[3])}; }
                }
                __syncthreads();
            }
        }
#endif
    }
    }
    for (int rpx = 0; rpx < REP_X; ++rpx) {
    PH(14) { PHASE_VARS
        const bf16* wsb = WSB(0);
        pg8::Gemm g{wsb, wsb, 2048, 2048, 256}; pg8::SchedKV S; S.init(G, bx, WS_KVM, WS_WMQ2, WS_WMO2);
        pg8::EpiBf16x2 E{WSB(WS_WK), WSB(WS_VW), DM, LOG2E / 16.f};
        pg8::gemm_phase(lds, xl, g, S, E);
    }
    }
    LSYNC();

    for (int rp = 0; rp < REP_3; ++rp) { if (rp) GSYNC();
    PH(3) { PHASE_VARS
        pg8::Gemm g{WSB(WS_CAT), WSB(WS_WOUT), DM, DM, DM}; pg8::Sched2D S; S.init(T, DM, G, bx, DM, DM);
        pg8::EpiRes<false> E{IN(0), WSB(WS_XN), WSF(WS_SS1)};
        pg8::gemm_phase(lds, xl, g, S, E);
    } }
    LSYNC();
    for (int rp = 0; rp < REP_4; ++rp) { if (rp) GSYNC();
    PH(4) { PHASE_VARS
        pg8::Gemm g{WSB(WS_XN), WSB(WS_WK), DM, DM, DM}; pg8::Sched2D S; S.init(T, DM, G, bx, DM, DM, (size_t)DM * DM * 2);
        pg8::EpiSoftmax E{WSB(WS_P), DM, WSF(WS_SS1)};
        pg8::gemm_phase(lds, xl, g, S, E);
    } }
    LSYNC();
    PH(7) { PHASE_VARS
        pg8::Gemm g{WSB(WS_P), WSB(WS_VW), DM, DM, DM}; pg8::Sched2D S; S.init(T, DM, G, bx, DM, DM, (size_t)DM * DM * 2);
        pg8::EpiRes<true> E{WSB(WS_XN), WSB(WS_XN), WSF(WS_SS2)};
        pg8::gemm_phase(lds, xl, g, S, E);
    }
    LSYNC();
    for (int rp = 0; rp < REP_8; ++rp) { if (rp) GSYNC();
    PH(8) { PHASE_VARS
        pg8::Gemm g{WSB(WS_XN), WSB(WS_WGU), DM, DM, DM}; pg8::Sched2D S; S.init(T, 2 * DFF, G, bx, DM, DM);
        pg8::EpiSwiGLU E{WSB(WS_HMID), DFF, WSF(WS_SS2)};
        pg8::gemm_phase(lds, xl, g, S, E);
    } }
    LSYNC();
    for (int rp = 0; rp < REP_9; ++rp) { if (rp) GSYNC();
    PH(9) { PHASE_VARS
        pg8::Gemm g{WSB(WS_HMID), WSB(WS_WDN), DFF, DFF, DFF}; pg8::Sched2D S; S.init(T, DM, G, bx, DFF, DFF);
        if (G == 256) {
            pg8::EpiFinal E{WSB(WS_XN), OUTP, IN(18), WSF(WS_SS3), (unsigned*)WSF(WS_CNT)};
            pg8::gemm_phase(lds, xl, g, S, E);
        } else {
            pg8::EpiResF32 E{WSB(WS_XN), OUTP};
            pg8::gemm_phase(lds, xl, g, S, E);
        }
    } }
    if (gridDim.x != 256) {
        GSYNC();
        { PHASE_VARS
            const float* g_final = IN(18); float* out = OUTP;
            f32x4 gg[4];
#pragma unroll
            for (int j = 0; j < 4; ++j) gg[j] = ((const f32x4*)g_final)[64 * j + lane];
            for (int m = gw; m < T; m += NGW) {
                f32x4* xr = (f32x4*)(out + (size_t)m * DM) + lane;
                f32x4 v[4]; float s = 0.f;
#pragma unroll
                for (int j = 0; j < 4; ++j) { v[j] = xr[64 * j]; s += (v[j][0] * v[j][0] + v[j][1] * v[j][1]) + (v[j][2] * v[j][2] + v[j][3] * v[j][3]); }
                const float rs = 1.0f / sqrtf(wave_sum(s) * (1.f / DM) + EPS);
#pragma unroll
                for (int j = 0; j < 4; ++j) xr[64 * j] = v[j] * rs * gg[j];
            }
        }
    }
    for (int xs = 0; xs < XSYNC; ++xs) GSYNC();
}

extern "C" void kernel_launch(void* const* d_in, const int* in_sizes, int n_in, void* d_out, int out_size, void* d_ws, size_t ws_size, hipStream_t stream) {
    static int grid = 0;
    if (grid == 0) {
        if (n_in != 19 || ws_size < WS_END) { fprintf(stderr, "kernel_launch: unexpected n_in %d / ws_size %zu\n", n_in, ws_size); grid = -1; return; }
        int dev = 0, cus = 0, per_cu = 0;
        (void)hipGetDevice(&dev); (void)hipDeviceGetAttribute(&cus, hipDeviceAttributeMultiprocessorCount, dev);
        (void)hipFuncSetAttribute((const void*)mk_fwd, hipFuncAttributeMaxDynamicSharedMemorySize, LDS_BYTES);
        (void)hipOccupancyMaxActiveBlocksPerMultiprocessor(&per_cu, (const void*)mk_fwd, NWAVES * 64, LDS_BYTES);
        if (per_cu < 1) { fprintf(stderr, "kernel_launch: occupancy query says %d blocks per CU\n", per_cu); per_cu = 1; }
        grid = cus * 1;
        (void)hipGetLastError();
    }
    if (grid < 0) return;
    if (!CGFIRST) (void)hipMemsetAsync((char*)d_ws + WS_BAR, 0, 65536, stream);
    Args a{};
    for (int i = 0; i < 19; ++i) a.in[i] = (const float*)d_in[i];
    a.out = (float*)d_out; a.ws = (unsigned char*)d_ws;
    void* kargs[] = {&a};
    hipError_t e = hipLaunchCooperativeKernel((const void*)mk_fwd, dim3(grid), dim3(NWAVES * 64), kargs, LDS_BYTES, stream);
    if (e != hipSuccess) fprintf(stderr, "cooperative launch failed: %s (grid %d)\n", hipGetErrorString(e), grid);
}
```

```cpp
#include <hip/hip_runtime.h>
#include <hip/hip_cooperative_groups.h>
#include <hip/hip_bf16.h>
#include <cstdio>
#include <cstdint>
#include <cmath>
namespace cg = cooperative_groups;

constexpr int NB = 16, SEQ = 2048, DM = 1024, T = NB * SEQ, DIN = 2568, DFF = 2816, ML = 256;
constexpr int ZP = 2560;
constexpr float EPS = 1e-6f, LOG2E = 1.4426950408889634f;

namespace pg8 {
#define PG8_LAS __attribute__((address_space(3)))
typedef unsigned short bf16_t;
typedef short bf16x8 __attribute__((ext_vector_type(8)));
typedef float f32x4 __attribute__((ext_vector_type(4)));
typedef float f32x2 __attribute__((ext_vector_type(2)));
typedef unsigned u32x4 __attribute__((ext_vector_type(4)));
constexpr int BM = 256, BK = 64, HALF = 128, HTB = HALF * BK * 2, STAGE_BYTES = 8 * HTB, NXCD = 8, WGM = 8;

__host__ __device__ __forceinline__ int lds_byte(int r, int c) { const int st = (r >> 4) * 2 + (c >> 5), rr = r & 15, cc = c & 31, ob = rr * 64 + cc * 2; return st * 1024 + (ob ^ (((ob >> 9) & 1) << 5)); }
__host__ __device__ __forceinline__ void stage_rc(int b, int& R, int& C) { const int st = b / 1024, sb = b % 1024, swz = sb ^ (((sb >> 9) & 1) << 5); R = (st >> 1) * 16 + swz / 64; C = (st & 1) * 32 + (swz % 64) / 2; }
__host__ __device__ __forceinline__ int perm32(int rho) { const int n = rho >> 4, i = rho & 15; return 8 * (i >> 2) + 4 * n + (i & 3); }

struct Unit { size_t aoff, boff; int r0, c0, sel; };
struct Gemm { const bf16_t* A; const bf16_t* Bt; int lda, ldb, K; };

__device__ __forceinline__ int xcd_remap(int L, int nwg) { const int q = nwg / NXCD, r = nwg % NXCD, xcd = L % NXCD, off = L / NXCD; return (xcd < r ? xcd * (q + 1) : r * (q + 1) + (xcd - r) * q) + off; }

struct Sched2D {
    int nM, nN, nwg, G, c, perm; size_t atile, btile, bbatch;
    __device__ void init(int M, int N, int G_, int c_, int lda, int ldb, size_t bbatch_ = 0, int perm_ = 0) { nM = M / BM; nN = N / BM; nwg = nM * nN; G = G_; c = c_; perm = perm_; atile = (size_t)BM * lda * 2; btile = (size_t)BM * ldb * 2; bbatch = bbatch_; }
    __device__ bool next(int i, Unit& u) const {
        const long L = (long)i * G + c; if (L >= nwg) return false;
        const int wgid = xcd_remap((int)L, nwg);
        const int nig = WGM * nN, gid = wgid / nig, fm = gid * WGM, gsz = (nM - fm) < WGM ? (nM - fm) : WGM;
        int pm = fm + ((wgid % nig) % gsz); const int pn = (wgid % nig) / gsz;
        if (perm) { const int x = pm >> 4, j = pm & 15; pm = (j < 8) ? 8 * x + j : 64 + 8 * x + (j - 8); } u.aoff = (size_t)pm * atile; u.boff = (size_t)pn * btile + (size_t)(pm >> 3) * bbatch; u.r0 = pm * BM; u.c0 = pn * BM; u.sel = 0; return true;
    }
};
struct SchedKV {
    int G, c; size_t oKVM, oWMQ, oWMO;
    __device__ void init(int G_, int c_, size_t kvm, size_t wmq, size_t wmo) { G = G_; c = c_; oKVM = kvm; oWMQ = wmq; oWMO = wmo; }
    __device__ bool next(int i, Unit& u) const {
        const long L = (long)i * G + c; if (L >= 512) return false;
        const int sel = (int)(L >> 8); const int w = xcd_remap((int)(L & 255), 256); const int z = w >> 2, t4 = w & 3, b = z >> 2, h = z & 3;
        u.sel = sel;
        if (sel == 0) { u.aoff = oKVM + ((size_t)(b * ML) * 2048 + h * 256) * 2; u.boff = oWMQ + ((size_t)(t4 * 256) * 2048 + h * 256) * 2; u.r0 = b * DM + h * 256; u.c0 = t4 * 256; }
        else { u.aoff = oWMO + ((size_t)(t4 * 256) * 2048 + h * 256) * 2; u.boff = oKVM + ((size_t)(b * ML) * 2048 + DM + h * 256) * 2; u.r0 = b * DM + t4 * 256; u.c0 = h * 256; }
        return true;
    }
};

__device__ __forceinline__ unsigned cvt_pk_bf16(float lo, float hi) { unsigned r; asm volatile("v_cvt_pk_bf16_f32 %0, %1, %2" : "=v"(r) : "v"(lo), "v"(hi)); return r; }
__device__ __forceinline__ u32x4 pack8(f32x4 v0, f32x4 v1) { u32x4 w; w.x = cvt_pk_bf16(v0[0], v0[1]); w.y = cvt_pk_bf16(v0[2], v0[3]); w.z = cvt_pk_bf16(v1[0], v1[1]); w.w = cvt_pk_bf16(v1[2], v1[3]); return w; }

typedef f32x4 Acc[2][2][4][2];
struct EpiBf16 {
    bf16_t* O; int ldc; int sc_lo, sc_hi; float sc;
    __device__ __forceinline__ void operator()(Acc& acc, const Unit& u, int wr, int wc, int fr, int fq, PG8_LAS unsigned char*) const {
        const float s = (u.c0 >= sc_lo && u.c0 < sc_hi) ? sc : 1.f;
        bf16_t* base = O + (size_t)(u.r0 + wr * 64 + fr) * ldc + u.c0 + wc * 32 + 8 * fq;
#pragma unroll
        for (int ai = 0; ai < 2; ++ai)
#pragma unroll
            for (int m = 0; m < 4; ++m) { bf16_t* rowp = base + (size_t)(ai * HALF + m * 16) * ldc;
#pragma unroll
                for (int bj = 0; bj < 2; ++bj) *(u32x4*)(rowp + bj * HALF) = pack8(acc[ai][bj][m][0] * s, acc[ai][bj][m][1] * s); }
    }
};
struct EpiBf16x2 {
    bf16_t* O0; bf16_t* O1; int ldc; float sc0;
    __device__ __forceinline__ void operator()(Acc& acc, const Unit& u, int wr, int wc, int fr, int fq, PG8_LAS unsigned char*) const {
        const float s = u.sel ? 1.f : sc0;
        bf16_t* base = (u.sel ? O1 : O0) + (size_t)(u.r0 + wr * 64 + fr) * ldc + u.c0 + wc * 32 + 8 * fq;
#pragma unroll
        for (int ai = 0; ai < 2; ++ai)
#pragma unroll
            for (int m = 0; m < 4; ++m) { bf16_t* rowp = base + (size_t)(ai * HALF + m * 16) * ldc;
#pragma unroll
                for (int bj = 0; bj < 2; ++bj) *(u32x4*)(rowp + bj * HALF) = pack8(acc[ai][bj][m][0] * s, acc[ai][bj][m][1] * s); }
    }
};
struct EpiZ {
    bf16_t* O; int ldc; float sc;
    __device__ __forceinline__ void operator()(Acc& acc, const Unit& u, int wr, int wc, int fr, int fq, PG8_LAS unsigned char*) const {
        if (u.c0 < 1024) {
            bf16_t* base = O + (size_t)(u.r0 + wr * 64 + fr) * ldc + (u.c0 >> 1) + wc * 32 + 8 * fq;
#pragma unroll
            for (int ai = 0; ai < 2; ++ai)
#pragma unroll
                for (int m = 0; m < 4; ++m) { f32x4 o[2];
#pragma unroll
                    for (int n = 0; n < 2; ++n) { const f32x4 uu = acc[ai][0][m][n], g = acc[ai][1][m][n]; f32x4 r;
#pragma unroll
                        for (int e = 0; e < 4; ++e) r[e] = uu[e] * __builtin_amdgcn_rcpf(1.f + __builtin_amdgcn_exp2f(-LOG2E * g[e]));
                        o[n] = r; }
                    *(u32x4*)(base + (size_t)(ai * HALF + m * 16) * ldc) = pack8(o[0], o[1]); }
        } else {
            const float s = (u.c0 < 1536) ? sc : 1.f;
            bf16_t* base = O + (size_t)(u.r0 + wr * 64 + fr) * ldc + u.c0 + wc * 32 + 8 * fq;
#pragma unroll
            for (int ai = 0; ai < 2; ++ai)
#pragma unroll
                for (int m = 0; m < 4; ++m) { bf16_t* rowp = base + (size_t)(ai * HALF + m * 16) * ldc;
#pragma unroll
                    for (int bj = 0; bj < 2; ++bj) *(u32x4*)(rowp + bj * HALF) = pack8(acc[ai][bj][m][0] * s, acc[ai][bj][m][1] * s); }
        }
    }
};
__device__ __forceinline__ void unpack8(u32x4 w, f32x4& v0, f32x4& v1) {
    v0 = (f32x4){__uint_as_float(w.x << 16), __uint_as_float(w.x & 0xffff0000u), __uint_as_float(w.y << 16), __uint_as_float(w.y & 0xffff0000u)};
    v1 = (f32x4){__uint_as_float(w.z << 16), __uint_as_float(w.z & 0xffff0000u), __uint_as_float(w.w << 16), __uint_as_float(w.w & 0xffff0000u)};
}
template <bool BASE_BF16> struct EpiRes {
    const void* base; bf16_t* outB; float* SS;
    __device__ __forceinline__ void operator()(Acc& acc, const Unit& u, int wr, int wc, int fr, int fq, PG8_LAS unsigned char* xl) const {
        PG8_LAS float* X = (PG8_LAS float*)xl;
        const int col = u.c0 + wc * 32 + 8 * fq;
#pragma unroll
        for (int ai = 0; ai < 2; ++ai)
#pragma unroll
            for (int m = 0; m < 4; ++m) { const int rl = ai * HALF + wr * 64 + m * 16 + fr; const int row = u.r0 + rl; const size_t off = (size_t)row * DM + col; float s = 0.f;
#pragma unroll
                for (int bj = 0; bj < 2; ++bj) {
                    f32x4 b0, b1;
                    if (BASE_BF16) unpack8(*(const u32x4*)((const bf16_t*)base + off + bj * HALF), b0, b1);
                    else { b0 = *(const f32x4*)((const float*)base + off + bj * HALF); b1 = *(const f32x4*)((const float*)base + off + bj * HALF + 4); }
                    const u32x4 w = pack8(acc[ai][bj][m][0] + b0, acc[ai][bj][m][1] + b1);
                    *(u32x4*)(outB + off + bj * HALF) = w;
                    f32x4 v0, v1; unpack8(w, v0, v1);
                    s += (v0[0] * v0[0] + v0[1] * v0[1]) + (v0[2] * v0[2] + v0[3] * v0[3]) + (v1[0] * v1[0] + v1[1] * v1[1]) + (v1[2] * v1[2] + v1[3] * v1[3]); }
                s += __shfl_xor(s, 16); s += __shfl_xor(s, 32);
                if (fq == 0) X[rl * 4 + wc] = s; }
        asm volatile("s_waitcnt lgkmcnt(0)" ::: "memory"); __builtin_amdgcn_s_barrier(); asm volatile("" ::: "memory");
        const int tid = threadIdx.x;
        if (tid < 256) SS[(size_t)(u.r0 + tid) * 4 + (u.c0 >> 8)] = (X[tid * 4 + 0] + X[tid * 4 + 1]) + (X[tid * 4 + 2] + X[tid * 4 + 3]);
    }
};
__device__ __forceinline__ const PG8_LAS float* rs_table(const float* SS, int r0, PG8_LAS unsigned char* xl) {
    PG8_LAS float* S = (PG8_LAS float*)(xl + 8192 + 256); const int tid = threadIdx.x;
    if (tid < 256) { const f32x4 p = *(const f32x4*)(SS + (size_t)(r0 + tid) * 4); S[tid] = 1.0f / sqrtf(((p[0] + p[1]) + (p[2] + p[3])) * (1.f / DM) + EPS); }
    asm volatile("s_waitcnt vmcnt(0) lgkmcnt(0)" ::: "memory"); __builtin_amdgcn_s_barrier(); asm volatile("" ::: "memory");
    return S;
}
struct EpiRs {
    bf16_t* O; int ldc; const float* SS; float sc;
    __device__ __forceinline__ void operator()(Acc& acc, const Unit& u, int wr, int wc, int fr, int fq, PG8_LAS unsigned char* xl) const {
        const PG8_LAS float* S = rs_table(SS, u.r0, xl);
#pragma unroll
        for (int ai = 0; ai < 2; ++ai)
#pragma unroll
            for (int m = 0; m < 4; ++m) { const int rl = ai * HALF + wr * 64 + m * 16 + fr; const int row = u.r0 + rl; const float s = S[rl] * sc;
                bf16_t* rowp = O + (size_t)row * ldc + u.c0 + wc * 32 + 8 * fq;
#pragma unroll
                for (int bj = 0; bj < 2; ++bj) *(u32x4*)(rowp + bj * HALF) = pack8(acc[ai][bj][m][0] * s, acc[ai][bj][m][1] * s); }
    }
};
struct EpiSwiGLU {
    bf16_t* H; int ldc; const float* SS;
    __device__ __forceinline__ void operator()(Acc& acc, const Unit& u, int wr, int wc, int fr, int fq, PG8_LAS unsigned char* xl) const {
        const PG8_LAS float* S = rs_table(SS, u.r0, xl);
#pragma unroll
        for (int ai = 0; ai < 2; ++ai)
#pragma unroll
            for (int m = 0; m < 4; ++m) { const int rl = ai * HALF + wr * 64 + m * 16 + fr; const int row = u.r0 + rl; const float s = S[rl];
                f32x4 o[2];
#pragma unroll
                for (int n = 0; n < 2; ++n) { const f32x4 g = acc[ai][0][m][n] * s, up = acc[ai][1][m][n] * s; f32x4 r;
#pragma unroll
                    for (int e = 0; e < 4; ++e) r[e] = g[e] * __builtin_amdgcn_rcpf(1.f + __builtin_amdgcn_exp2f(-LOG2E * g[e])) * up[e];
                    o[n] = r; }
                *(u32x4*)(H + (size_t)row * ldc + (u.c0 >> 1) + wc * 32 + 8 * fq) = pack8(o[0], o[1]); }
    }
};
struct EpiSoftmax {
    bf16_t* P; int ldc; const float* SS;
    __device__ __forceinline__ void operator()(Acc& acc, const Unit& u, int wr, int wc, int fr, int fq, PG8_LAS unsigned char* xl) const {
        const PG8_LAS float* S = rs_table(SS, u.r0, xl);
        PG8_LAS f32x2* X = (PG8_LAS f32x2*)xl;
#pragma unroll
        for (int ai = 0; ai < 2; ++ai)
#pragma unroll
            for (int m = 0; m < 4; ++m) { const int rl = ai * HALF + wr * 64 + m * 16 + fr; const float rs = S[rl];
                float mx = -INFINITY;
#pragma unroll
                for (int bj = 0; bj < 2; ++bj)
#pragma unroll
                    for (int n = 0; n < 2; ++n) { const f32x4 v = acc[ai][bj][m][n] * rs; acc[ai][bj][m][n] = v; mx = fmaxf(mx, fmaxf(fmaxf(v[0], v[1]), fmaxf(v[2], v[3]))); }
                mx = fmaxf(mx, __shfl_xor(mx, 16)); mx = fmaxf(mx, __shfl_xor(mx, 32));
                float s = 0.f;
#pragma unroll
                for (int bj = 0; bj < 2; ++bj)
#pragma unroll
                    for (int n = 0; n < 2; ++n) { f32x4 v = acc[ai][bj][m][n];
#pragma unroll
                        for (int e = 0; e < 4; ++e) { v[e] = __builtin_amdgcn_exp2f(v[e] - mx); s += v[e]; }
                        acc[ai][bj][m][n] = v; }
                s += __shfl_xor(s, 16); s += __shfl_xor(s, 32);
                if (fq == 0) X[rl * 4 + wc] = (f32x2){mx, s};
            }
        asm volatile("s_waitcnt lgkmcnt(0)" ::: "memory"); __builtin_amdgcn_s_barrier(); asm volatile("" ::: "memory");
#pragma unroll
        for (int ai = 0; ai < 2; ++ai)
#pragma unroll
            for (int m = 0; m < 4; ++m) { const int rl = ai * HALF + wr * 64 + m * 16 + fr;
                const f32x2 a = X[rl * 4 + 0], b = X[rl * 4 + 1], c = X[rl * 4 + 2], d = X[rl * 4 + 3];
                const float M = fmaxf(fmaxf(a.x, b.x), fmaxf(c.x, d.x));
                const float tot = a.y * __builtin_amdgcn_exp2f(a.x - M) + b.y * __builtin_amdgcn_exp2f(b.x - M) + c.y * __builtin_amdgcn_exp2f(c.x - M) + d.y * __builtin_amdgcn_exp2f(d.x - M);
                const float own = wc == 0 ? a.x : wc == 1 ? b.x : wc == 2 ? c.x : d.x;
                const float f = __builtin_amdgcn_exp2f(own - M) / tot;
                bf16_t* rowp = P + (size_t)(u.r0 + rl) * ldc + u.c0 + wc * 32 + 8 * fq;
#pragma unroll
                for (int bj = 0; bj < 2; ++bj) *(u32x4*)(rowp + bj * HALF) = pack8(acc[ai][bj][m][0] * f, acc[ai][bj][m][1] * f); }
    }
};
struct EpiFinal {
    const bf16_t* base; float* out; const float* gfin; float* SS3; unsigned* cnt;
    __device__ __forceinline__ void operator()(Acc& acc, const Unit& u, int wr, int wc, int fr, int fq, PG8_LAS unsigned char* xl) const {
        PG8_LAS float* X = (PG8_LAS float*)xl;
        PG8_LAS float* S = X + 1024;
        const int tid = threadIdx.x, lane = tid & 63, wid = __builtin_amdgcn_readfirstlane(tid >> 6);
        const int col = u.c0 + wc * 32 + 8 * fq;
#pragma unroll
        for (int ai = 0; ai < 2; ++ai)
#pragma unroll
            for (int m = 0; m < 4; ++m) { const int rl = ai * HALF + wr * 64 + m * 16 + fr; const size_t off = (size_t)(u.r0 + rl) * DM + col; float s = 0.f;
#pragma unroll
                for (int bj = 0; bj < 2; ++bj) {
                    f32x4 b0, b1; unpack8(*(const u32x4*)(base + off + bj * HALF), b0, b1);
                    const f32x4 v0 = acc[ai][bj][m][0] + b0, v1 = acc[ai][bj][m][1] + b1;
                    acc[ai][bj][m][0] = v0; acc[ai][bj][m][1] = v1;
                    s += (v0[0] * v0[0] + v0[1] * v0[1]) + (v0[2] * v0[2] + v0[3] * v0[3]) + (v1[0] * v1[0] + v1[1] * v1[1]) + (v1[2] * v1[2] + v1[3] * v1[3]); }
                s += __shfl_xor(s, 16); s += __shfl_xor(s, 32);
                if (fq == 0) X[rl * 4 + wc] = s; }
        asm volatile("s_waitcnt lgkmcnt(0)" ::: "memory"); __builtin_amdgcn_s_barrier(); asm volatile("" ::: "memory");
        const int panel = u.r0 >> 8; unsigned* pc = cnt + 64 * panel;
        if (tid < 256) { const float tot = (X[tid * 4 + 0] + X[tid * 4 + 1]) + (X[tid * 4 + 2] + X[tid * 4 + 3]);
            __hip_atomic_store(SS3 + (size_t)(u.r0 + tid) * 4 + (u.c0 >> 8), tot, __ATOMIC_RELAXED, __HIP_MEMORY_SCOPE_AGENT); }
        asm volatile("s_waitcnt vmcnt(0)" ::: "memory");
        if (tid < 256 && lane == 0) __hip_atomic_fetch_add(pc, 1u, __ATOMIC_RELAXED, __HIP_MEMORY_SCOPE_AGENT);
        if (wid == 0) { unsigned sp = 0;
            while ((unsigned)__builtin_amdgcn_readfirstlane(__hip_atomic_load(pc, __ATOMIC_RELAXED, __HIP_MEMORY_SCOPE_AGENT)) < 16u) { __builtin_amdgcn_s_sleep(1); if (++sp > (1u << 22)) break; }
            __builtin_amdgcn_fence(__ATOMIC_ACQUIRE, "agent"); }
        asm volatile("s_waitcnt vmcnt(0) lgkmcnt(0)" ::: "memory"); __builtin_amdgcn_s_barrier(); asm volatile("" ::: "memory");
        if (tid < 256) { const float* sl = SS3 + (size_t)(u.r0 + tid) * 4;
            const float q = (__hip_atomic_load(sl + 0, __ATOMIC_RELAXED, __HIP_MEMORY_SCOPE_AGENT) + __hip_atomic_load(sl + 1, __ATOMIC_RELAXED, __HIP_MEMORY_SCOPE_AGENT))
                          + (__hip_atomic_load(sl + 2, __ATOMIC_RELAXED, __HIP_MEMORY_SCOPE_AGENT) + __hip_atomic_load(sl + 3, __ATOMIC_RELAXED, __HIP_MEMORY_SCOPE_AGENT));
            S[tid] = 1.0f / sqrtf(q * (1.f / DM) + EPS); }
        asm volatile("s_waitcnt vmcnt(0) lgkmcnt(0)" ::: "memory"); __builtin_amdgcn_s_barrier(); asm volatile("" ::: "memory");
        f32x4 gv[2][2];
#pragma unroll
        for (int bj = 0; bj < 2; ++bj) { gv[bj][0] = *(const f32x4*)(gfin + col + bj * HALF); gv[bj][1] = *(const f32x4*)(gfin + col + bj * HALF + 4); }
#pragma unroll
        for (int ai = 0; ai < 2; ++ai)
#pragma unroll
            for (int m = 0; m < 4; ++m) { const int rl = ai * HALF + wr * 64 + m * 16 + fr; const float rs = S[rl]; const size_t off = (size_t)(u.r0 + rl) * DM + col;
#pragma unroll
                for (int bj = 0; bj < 2; ++bj) { *(f32x4*)(out + off + bj * HALF) = acc[ai][bj][m][0] * rs * gv[bj][0]; *(f32x4*)(out + off + bj * HALF + 4) = acc[ai][bj][m][1] * rs * gv[bj][1]; } }
    }
};

struct EpiResF32 {
    const bf16_t* base; float* out;
    __device__ __forceinline__ void operator()(Acc& acc, const Unit& u, int wr, int wc, int fr, int fq, PG8_LAS unsigned char*) const {
        const int col = u.c0 + wc * 32 + 8 * fq;
#pragma unroll
        for (int ai = 0; ai < 2; ++ai)
#pragma unroll
            for (int m = 0; m < 4; ++m) { const size_t off = (size_t)(u.r0 + ai * HALF + wr * 64 + m * 16 + fr) * DM + col;
#pragma unroll
                for (int bj = 0; bj < 2; ++bj) { f32x4 b0, b1; unpack8(*(const u32x4*)(base + off + bj * HALF), b0, b1);
                    *(f32x4*)(out + off + bj * HALF) = acc[ai][bj][m][0] + b0; *(f32x4*)(out + off + bj * HALF + 4) = acc[ai][bj][m][1] + b1; } }
    }
};
template <class Epi, class Sched>
__device__ __forceinline__ void gemm_phase(PG8_LAS unsigned char* lds, PG8_LAS unsigned char* xl, const Gemm g, const Sched& S, const Epi& E) {
    int tid_ = threadIdx.x; asm volatile("" : "+v"(tid_));
    const int tid = tid_, wid = __builtin_amdgcn_readfirstlane(tid >> 6), lane = tid & 63, wr = wid >> 2, wc = wid & 3, fr = lane & 15, fq = lane >> 4;
    const int K = g.K, nt = K / BK;
    unsigned voffA[2], voffB[2];
#pragma unroll
    for (int i = 0; i < 2; ++i) { int R, C; stage_rc(tid * 16 + i * 8192, R, C); const int Rb = (R & ~31) + perm32(R & 31);
        voffA[i] = (unsigned)(R * g.lda + C) * 2u; voffB[i] = (unsigned)(Rb * g.ldb + C) * 2u; }
    const size_t kstep = (size_t)(BK * 2);
    const size_t hsA = (size_t)HALF * g.lda * 2, hsB = (size_t)HALF * g.ldb * 2;
    const unsigned ldsw = (unsigned)wid * 1024u;
    const int aoff = lds_byte(wr * 64 + fr, fq * 8), boff = lds_byte(wc * 32 + fr, fq * 8);
#define PG8_SA(b, h) (((b) * 2 + (h)) * HTB)
#define PG8_SB(b, h) ((4 + (b) * 2 + (h)) * HTB)
#define PG8_STAGE(bufoff, gbase, voff) do { _Pragma("unroll") for (int _i = 0; _i < 2; ++_i) \
        __builtin_amdgcn_global_load_lds((const unsigned*)((const char*)(gbase) + (voff)[_i]), (PG8_LAS unsigned*)(lds + (bufoff) + ldsw + _i * 8192), 16, 0, 0); } while (0)
#define PG8_LDA(dst, b, h) do { _Pragma("unroll") for (int m = 0; m < 4; ++m) _Pragma("unroll") for (int k = 0; k < 2; ++k) dst[m][k] = *(const PG8_LAS bf16x8*)(lds + PG8_SA(b, h) + aoff + m * 2048 + k * 1024); } while (0)
#define PG8_LDB(dst, b, h) do { _Pragma("unroll") for (int n = 0; n < 2; ++n) _Pragma("unroll") for (int k = 0; k < 2; ++k) dst[n][k] = *(const PG8_LAS bf16x8*)(lds + PG8_SB(b, h) + boff + n * 2048 + k * 1024); } while (0)
#define PG8_MMA(ai, bj, At, Bt) do { __builtin_amdgcn_s_setprio(1); _Pragma("unroll") for (int m = 0; m < 4; ++m) _Pragma("unroll") for (int n = 0; n < 2; ++n) _Pragma("unroll") for (int k = 0; k < 2; ++k) \
        acc[ai][bj][m][n] = __builtin_amdgcn_mfma_f32_16x16x32_bf16(Bt[n][k], At[m][k], acc[ai][bj][m][n], 0, 0, 0); __builtin_amdgcn_s_setprio(0); } while (0)
#define PG8_WAIT_V(n) asm volatile("s_waitcnt vmcnt(" #n ")" ::: "memory")
#define PG8_WAIT_L(n) asm volatile("s_waitcnt lgkmcnt(" #n ")" ::: "memory")
#define PG8_BAR __builtin_amdgcn_s_barrier()
#define PG8_SCHED __builtin_amdgcn_sched_barrier(0)
    Unit cur, nxt; int ui = 0;
    if (!S.next(0, cur)) return;
    Acc acc;
#pragma unroll
    for (int a = 0; a < 2; ++a)
#pragma unroll
        for (int b = 0; b < 2; ++b)
#pragma unroll
            for (int m = 0; m < 4; ++m)
#pragma unroll
                for (int n = 0; n < 2; ++n) acc[a][b][m][n] = (f32x4){0.f, 0.f, 0.f, 0.f};
    bf16x8 At[4][2], B0[2][2], B1[2][2];
    const char* cA = (const char*)g.A + cur.aoff; const char* cB = (const char*)g.Bt + cur.boff;
    PG8_STAGE(PG8_SB(0, 0), cB, voffB); PG8_STAGE(PG8_SB(0, 1), cB + hsB, voffB); PG8_STAGE(PG8_SA(0, 0), cA, voffA); PG8_STAGE(PG8_SA(0, 1), cA + hsA, voffA);
    if (wr == 1) PG8_BAR;
    PG8_WAIT_V(2); PG8_BAR;
    PG8_STAGE(PG8_SB(1, 0), cB + kstep, voffB); PG8_STAGE(PG8_SA(1, 0), cA + kstep, voffA); PG8_STAGE(PG8_SB(1, 1), cB + hsB + kstep, voffB);
    PG8_WAIT_V(6); PG8_BAR;
    for (;;) {
        const bool has_next = S.next(ui + 1, nxt);
        const char* nA = has_next ? (const char*)g.A + nxt.aoff : cA; const char* nB = has_next ? (const char*)g.Bt + nxt.boff : cB;
#pragma unroll 1
        for (int t = 0; t < nt; t += 2) {
            const bool last = (t == nt - 2);
            const char* a1 = cA + (size_t)(t + 1) * kstep;
            const char* a2 = last ? nA : cA + (size_t)(t + 2) * kstep; const char* b2 = last ? nB : cB + (size_t)(t + 2) * kstep;
            const char* a3 = a2 + kstep; const char* b3 = b2 + kstep;
            PG8_LDB(B0, 0, 0); PG8_LDB(B1, 0, 1); PG8_SCHED; PG8_LDA(At, 0, 0); PG8_STAGE(PG8_SA(1, 1), a1 + hsA, voffA);
            PG8_WAIT_V(8); PG8_WAIT_L(0); PG8_BAR; PG8_MMA(0, 0, At, B0); PG8_MMA(0, 1, At, B1); PG8_BAR; PG8_SCHED;
            PG8_LDA(At, 0, 1); PG8_STAGE(PG8_SB(0, 0), b2, voffB); PG8_STAGE(PG8_SB(0, 1), b2 + hsB, voffB); PG8_STAGE(PG8_SA(0, 0), a2, voffA);
            PG8_WAIT_V(8); PG8_WAIT_L(0); PG8_BAR; PG8_MMA(1, 0, At, B0); PG8_MMA(1, 1, At, B1); PG8_BAR; PG8_SCHED;
            PG8_LDB(B0, 1, 0); PG8_LDB(B1, 1, 1); PG8_SCHED; PG8_LDA(At, 1, 0); PG8_STAGE(PG8_SA(0, 1), a2 + hsA, voffA);
            PG8_WAIT_V(8); PG8_WAIT_L(0); PG8_BAR; PG8_MMA(0, 0, At, B0); PG8_MMA(0, 1, At, B1); PG8_BAR; PG8_SCHED;
            PG8_LDA(At, 1, 1); PG8_STAGE(PG8_SB(1, 0), b3, voffB); PG8_STAGE(PG8_SB(1, 1), b3 + hsB, voffB); PG8_STAGE(PG8_SA(1, 0), a3, voffA);
            PG8_WAIT_V(8); PG8_WAIT_L(0); PG8_BAR; PG8_MMA(1, 0, At, B0); PG8_MMA(1, 1, At, B1); PG8_BAR; PG8_SCHED;
        }
        if (wr == 0) PG8_BAR;
        E(acc, cur, wr, wc, fr, fq, xl);
        if (!has_next) break;
#pragma unroll
        for (int a = 0; a < 2; ++a)
#pragma unroll
            for (int b = 0; b < 2; ++b)
#pragma unroll
                for (int m = 0; m < 4; ++m)
#pragma unroll
                    for (int n = 0; n < 2; ++n) acc[a][b][m][n] = (f32x4){0.f, 0.f, 0.f, 0.f};
        cur = nxt; cA = nA; cB = nB; ++ui;
        if (wr == 1) PG8_BAR;
    }
    PG8_WAIT_V(0);
    PG8_BAR;
#undef PG8_SA
#undef PG8_SB
#undef PG8_STAGE
#undef PG8_LDA
#undef PG8_LDB
#undef PG8_MMA
#undef PG8_WAIT_V
#undef PG8_WAIT_L
#undef PG8_BAR
#undef PG8_SCHED
}
}

namespace attn_body {
using bf16 = __hip_bfloat16;
using bf16x8 = __attribute__((ext_vector_type(8))) short;
using s16x4 = __attribute__((ext_vector_type(4))) short;
using f32x16 = __attribute__((ext_vector_type(16))) float;
using f32x4 = __attribute__((ext_vector_type(4))) float;
using u32x4 = __attribute__((ext_vector_type(4))) unsigned;
constexpr int D = 64, KP = ZP, OP = DM;
constexpr int NW = 8, QBLK = 32, QB = QBLK * NW, KVBLK = 64;
__device__ __forceinline__ int crow(int r, int hi) { return (r & 3) + 8 * (r >> 2) + 4 * hi; }
#define SBAR() __builtin_amdgcn_sched_barrier(0)
__device__ __forceinline__ void cmask(f32x16& p0, f32x16& p1, int jb, int qrel, int hi) {
    const float NEG = -INFINITY; int kb = 64 * jb + 4 * hi;
#pragma unroll
    for (int r = 0; r < 16; ++r) { int kv = kb + (r & 3) + 8 * (r >> 2); if (kv > qrel) p0[r] = NEG; if (kv + 32 > qrel) p1[r] = NEG; }
}
constexpr int NSLOT = 3, SLOTB = 8192;
constexpr int LDS_K = 0, LDS_V = NSLOT * SLOTB, LDS_WS = 2 * NSLOT * SLOTB, LDS_OST = LDS_WS + NW * 64 * 4, LDS_KX = LDS_OST + NW * 4096, LDS_BYTES = LDS_KX + SEQ * 16 + 16;
constexpr float C2 = 0.125f * 1.4426950408889634f;
__device__ __forceinline__ void glds16(const void* gsrc, unsigned lds_dst) { unsigned keep;
    asm volatile("s_mov_b32 %0, m0\n\ts_mov_b32 m0, %2\n\ts_nop 0\n\tglobal_load_lds_dwordx4 %1, off\n\ts_mov_b32 m0, %0" : "=&s"(keep) : "v"(gsrc), "s"(lds_dst) : "memory"); }
__device__ __forceinline__ float max3f(float a, float b, float c) { float r; asm("v_max3_f32 %0, %1, %2, %3" : "=v"(r) : "v"(a), "v"(b), "v"(c)); return r; }
__device__ __forceinline__ float max2f(float a, float b) { float r; asm("v_max_f32_e32 %0, %1, %2" : "=v"(r) : "v"(a), "v"(b)); return r; }
__device__ __forceinline__ float fadd_s(float a, float b) { float r; asm("v_add_f32_e32 %0, %1, %2" : "=v"(r) : "v"(a), "v"(b)); return r; }
__device__ __forceinline__ float fsub_s(float a, float b) { float r; asm("v_sub_f32_e32 %0, %1, %2" : "=v"(r) : "v"(a), "v"(b)); return r; }
typedef float f32x2_t __attribute__((ext_vector_type(2))); typedef __bf16 bf16x2_t __attribute__((ext_vector_type(2)));
__device__ __forceinline__ unsigned cvtpk_s(float lo, float hi) { f32x2_t v = {lo, hi}; bf16x2_t b = __builtin_convertvector(v, bf16x2_t); return __builtin_bit_cast(unsigned, b); }
#define WAIT_BAR(N) asm volatile("s_waitcnt vmcnt(" #N ") lgkmcnt(0)\n\ts_barrier" ::: "memory")

__device__ __forceinline__ void qkt(f32x16& p0, f32x16& p1, const char* Kslot, const bf16x8* qr, const f32x16& negm, int r32, int hi, bf16x8 kx0, bf16x8 kx1, bf16x8 qx) {
    const char* kb = Kslot + hi * 1024 + r32 * 16;
#pragma unroll
    for (int d0 = 0; d0 < 4; ++d0) {
        const bf16x8 b0 = *reinterpret_cast<const bf16x8*>(kb + d0 * 2048);
        const bf16x8 b1 = *reinterpret_cast<const bf16x8*>(kb + d0 * 2048 + 512);
        if (d0 == 0) { p0 = __builtin_amdgcn_mfma_f32_32x32x16_bf16(b0, qr[0], negm, 0, 0, 0); p1 = __builtin_amdgcn_mfma_f32_32x32x16_bf16(b1, qr[0], negm, 0, 0, 0); }
        else { p0 = __builtin_amdgcn_mfma_f32_32x32x16_bf16(b0, qr[d0], p0, 0, 0, 0); p1 = __builtin_amdgcn_mfma_f32_32x32x16_bf16(b1, qr[d0], p1, 0, 0, 0); } }
    p0 = __builtin_amdgcn_mfma_f32_32x32x16_bf16(kx0, qx, p0, 0, 0, 0); p1 = __builtin_amdgcn_mfma_f32_32x32x16_bf16(kx1, qx, p1, 0, 0, 0);
}
typedef __attribute__((address_space(3))) const char* lds_cptr;
typedef short v4i16_t __attribute__((ext_vector_type(4)));
#define L3BF8 const __attribute__((address_space(3))) bf16x8
__device__ __forceinline__ void kload8(bf16x8* kf, lds_cptr kp) {
    kf[0] = *(L3BF8*)(kp);        kf[1] = *(L3BF8*)(kp + 512);
    kf[2] = *(L3BF8*)(kp + 2048); kf[3] = *(L3BF8*)(kp + 2560);
    kf[4] = *(L3BF8*)(kp + 4096); kf[5] = *(L3BF8*)(kp + 4608);
    kf[6] = *(L3BF8*)(kp + 6144); kf[7] = *(L3BF8*)(kp + 6656);
}
__device__ __forceinline__ void kload2(bf16x8* kf, lds_cptr kp, int j) { kf[2 * j] = *(L3BF8*)(kp + j * 2048); kf[2 * j + 1] = *(L3BF8*)(kp + j * 2048 + 512); }
__device__ __forceinline__ s16x4 vtr(lds_cptr p) { return __builtin_bit_cast(s16x4, __builtin_amdgcn_ds_read_tr16_b64_v4i16((__attribute__((address_space(3))) v4i16_t*)p)); }
__device__ __forceinline__ float rowmax(const f32x16& p0, const f32x16& p1) {
    float a = max3f(p0[0], p0[1], p1[0]), b = max3f(p0[2], p0[3], p1[1]); a = max3f(a, p1[2], p1[3]);
#pragma unroll
    for (int r = 4; r < 16; r += 4) { a = max3f(a, p0[r], p0[r + 1]); b = max3f(b, p0[r + 2], p0[r + 3]); a = max3f(a, p1[r], p1[r + 1]); b = max3f(b, p1[r + 2], p1[r + 3]); }
    const float m = max2f(a, b);
    auto rr = __builtin_amdgcn_permlane32_swap(__float_as_uint(m), __float_as_uint(m), false, false);
    return max2f(__uint_as_float(rr[0]), __uint_as_float(rr[1]));
}
__device__ __forceinline__ void pv(f32x16* o, int vb, bf16x8 pa0, bf16x8 pa1, bf16x8 pa2, bf16x8 pa3) {
#pragma unroll
    for (int d0 = 0; d0 < 2; ++d0) { s16x4 lo[4], hi[4];
#pragma unroll
        for (int ks = 0; ks < 4; ++ks) {
            asm volatile("ds_read_b64_tr_b16 %0,%1 offset:%c2" : "=&v"(lo[ks]) : "v"(vb), "i"(d0 * 4096 + ks * 1024) : "memory");
            asm volatile("ds_read_b64_tr_b16 %0,%1 offset:%c2" : "=&v"(hi[ks]) : "v"(vb), "i"(d0 * 4096 + ks * 1024 + 512) : "memory"); }
        asm volatile("s_waitcnt lgkmcnt(0)" ::: "memory"); SBAR();
#define PK(k) (bf16x8){lo[k][0], lo[k][1], lo[k][2], lo[k][3], hi[k][0], hi[k][1], hi[k][2], hi[k][3]}
        o[d0] = __builtin_amdgcn_mfma_f32_32x32x16_bf16(pa0, PK(0), o[d0], 0, 0, 0);
        o[d0] = __builtin_amdgcn_mfma_f32_32x32x16_bf16(pa1, PK(1), o[d0], 0, 0, 0);
        o[d0] = __builtin_amdgcn_mfma_f32_32x32x16_bf16(pa2, PK(2), o[d0], 0, 0, 0);
        o[d0] = __builtin_amdgcn_mfma_f32_32x32x16_bf16(pa3, PK(3), o[d0], 0, 0, 0);
#undef PK
    }
}
__device__ __forceinline__ void split3(float x, unsigned& b0, unsigned& b1, unsigned& b2) {
    b0 = cvtpk_s(x, 0.f) & 0xffffu; const float r1 = x - __uint_as_float(b0 << 16);
    b1 = cvtpk_s(r1, 0.f) & 0xffffu; const float r2 = r1 - __uint_as_float(b1 << 16);
    b2 = cvtpk_s(r2, 0.f) & 0xffffu;
}
__device__ __forceinline__ bf16x8 make_qx(float m, int hi) {
    unsigned b0, b1, b2; split3(m, b0, b1, b2);
    u32x4 w = (u32x4){0x3F803F80u, 0x3F80u | (b0 << 16), b1 | (b2 << 16), 0u};
    if (hi) w = (u32x4){0u, 0u, 0u, 0u};
    return __builtin_bit_cast(bf16x8, w);
}

template <int THRL> __device__ __forceinline__ void attn_unit(int b, int h, int qb, const bf16* Q, const bf16* __restrict__ K, const bf16* __restrict__ V, bf16* O, char* shm, bool first, int qb_next, bf16x8& qn0, bf16x8& qn1, bf16x8& qn2, bf16x8& qn3) {
    int tid_ = threadIdx.x; asm volatile("" : "+v"(tid_));
    const int tid = tid_, lane = tid & 63, r32 = lane & 31, hi = lane >> 5; const int wid = __builtin_amdgcn_readfirstlane(tid >> 6);
    const long rowbase = (long)b * SEQ; const int q0 = qb * QB;
    const bf16* Qw = Q + (rowbase + q0 + wid * QBLK) * KP + h * D;
    const bf16 *Kh = K + rowbase * KP + h * D, *Vh = V + rowbase * KP + h * D;
    const unsigned lds0 = (unsigned)(uintptr_t)shm;
    float* wsf = (float*)(shm + LDS_WS) + wid * 64;
    const bf16* ksrc = Kh + (long)lane * KP + wid * 8;
    const bf16* vsrc = Vh + (long)(16 * (wid & 3) + (lane >> 2)) * KP + (wid >> 2) * 32 + (lane & 3) * 8;
    const unsigned kdst = lds0 + LDS_K + wid * 1024, vdst = lds0 + LDS_V + wid * 1024;
#define DMA_K(t, slot) glds16(ksrc + (long)(t) * KVBLK * KP, (unsigned)__builtin_amdgcn_readfirstlane(kdst + (slot)))
#define DMA_V(t, slot) glds16(vsrc + (long)(t) * KVBLK * KP, (unsigned)__builtin_amdgcn_readfirstlane(vdst + (slot)))
    const int vb0 = (int)(lds0 + LDS_V) + ((lane >> 4) & 1) * 32 + (lane & 3) * 8 + (4 * hi + ((lane & 15) >> 2)) * 64;
    const char* Kbase = shm + LDS_K; bf16x8 kf[8];
    const lds_cptr shm3 = (lds_cptr)shm; const lds_cptr kxp = hi ? (shm3 + LDS_KX + SEQ * 16) : (shm3 + LDS_KX + r32 * 16); const int kxstep = hi ? 0 : 1024, kxoff2 = hi ? 0 : 512;
    bf16x8 kx[2];
#define KXRD(tt) do { const lds_cptr p_ = kxp + (tt) * kxstep; kx[0] = *(L3BF8*)(p_); kx[1] = *(L3BF8*)(p_ + kxoff2); } while (0)
    const lds_cptr kp0 = shm3 + LDS_K + hi * 1024 + r32 * 16; const lds_cptr vp0 = shm3 + LDS_V + ((lane >> 4) & 1) * 32 + (lane & 3) * 8 + (4 * hi + ((lane & 15) >> 2)) * 64;
    const int NT = (q0 + QB) / KVBLK;
    if (first) { DMA_K(0, 0); DMA_V(0, 0); DMA_K(1, SLOTB); } else { DMA_V(0, 0); }
    bf16x8 qr[4];
    if (first) {
#pragma unroll
        for (int d0 = 0; d0 < 4; ++d0) qr[d0] = *reinterpret_cast<const bf16x8*>(&Qw[(long)r32 * KP + d0 * 16 + hi * 8]);
    } else { qr[0] = qn0; qr[1] = qn1; qr[2] = qn2; qr[3] = qn3; }
    const int qrel = wid * QBLK + r32;
    float mhat = 0.f, l_reg = 0.f; f32x16 o[2]; o[0] = f32x16{}; o[1] = f32x16{}; const f32x16 negm = f32x16{}; bf16x8 qx = make_qx(0.f, hi);
#define CMASK(P0, P1, t) do { int jb_ = (t) - (NT - 4); if (jb_ >= 0) cmask(P0, P1, jb_, qrel, hi); } while (0)
    bool resc = false;
#define START(P0, P1) do { const float rm = rowmax(P0, P1); resc = false; \
    { const float dl = rm; mhat = fadd_s(mhat, dl); \
      _Pragma("unroll") for (int r = 0; r < 16; ++r) { P0[r] = fsub_s(P0[r], dl); P1[r] = fsub_s(P1[r], dl); } \
      qx = make_qx(-mhat, hi); } \
    _Pragma("unroll") for (int r = 0; r < 16; ++r) P0[r] = __builtin_amdgcn_exp2f(P0[r]); } while (0)
#define RESC() do { if (resc) { asm volatile("s_waitcnt lgkmcnt(0)" ::: "memory"); \
      _Pragma("unroll") for (int d_ = 0; d_ < 2; ++d_) _Pragma("unroll") for (int r = 0; r < 16; ++r) o[d_][r] *= wsf[crow(r, hi)]; } } while (0)
    f32x16 pA0, pA1, pB0, pB1;
    int sl_prev = 0, sl_cur = 0, sl_next = SLOTB;
#define ROT() do { sl_prev = sl_cur; sl_cur = sl_next; sl_next = (sl_next == (NSLOT - 1) * SLOTB) ? 0 : sl_next + SLOTB; } while (0)
    if (first) { DMA_K(2, 2 * SLOTB); WAIT_BAR(3); }
    else { WAIT_BAR(1); }
    KXRD(0);
    qkt(pA0, pA1, Kbase, qr, negm, r32, hi, kx[0], kx[1], qx); asm volatile("s_nop 15\n\ts_nop 7" : "+v"(pA0), "+v"(pA1)); CMASK(pA0, pA1, 0);
    START(pA0, pA1);
    _Pragma("unroll") for (int r = 0; r < 16; ++r) pA1[r] = __builtin_amdgcn_exp2f(pA1[r]);
    WAIT_BAR(0);
    DMA_K(3, 0); DMA_V(1, SLOTB);
    ROT();
    kload8(kf, kp0 + sl_cur); KXRD(1);
    WAIT_BAR(2);
    s16x4 vlo[8], vhi[8]; u32x4 pw0, pw1, pw2, pw3;
#define PKW(P, B) cvtpk_s(P[B], P[B + 1])
#define PAF(k) __builtin_bit_cast(bf16x8, pw##k)
#define VFR(i) (bf16x8){vlo[i][0], vlo[i][1], vlo[i][2], vlo[i][3], vhi[i][0], vhi[i][1], vhi[i][2], vhi[i][3]}
#define PIN(x) asm volatile("" : "+v"(x))
#define MX3(a, b, c) __builtin_fmaxf(__builtin_fmaxf((a), (b)), (c))
#define GAPA(MF, A0, A1, A2, A3, W0, W1, PW) do { MF; sacc += A0; sacc += A1; sacc += A2; sacc += A3; PIN(sacc); W0; W1; PIN(PW); SBAR(); } while (0)
#define EX(v) __builtin_amdgcn_exp2f(v)
#define GAPB(MF, X, B) do { MF; X[B] = EX(X[B]); X[B + 1] = EX(X[B + 1]); X[B + 2] = EX(X[B + 2]); X[B + 3] = EX(X[B + 3]); PIN(X); SBAR(); } while (0)
#define VRD(i) do { vlo[i] = vtr(vp_ + (((i) >> 2) * 4096 + ((i) & 3) * 1024)); vhi[i] = vtr(vp_ + (((i) >> 2) * 4096 + ((i) & 3) * 1024 + 512)); } while (0)
#define KRD(G, j) do { if (G) { kload2(kf, kp0 + sl_next, j); SBAR(); } } while (0)
#define STEP(C0, C1, P0, P1, t, GK, GV, GL) do { SBAR(); \
    const lds_cptr vp_ = vp0 + sl_prev; \
    VRD(0); SBAR(); float sacc = (P0[0] + P0[1]); \
    GAPA(C0 = __builtin_amdgcn_mfma_f32_32x32x16_bf16(kf[0], qr[0], negm, 0, 0, 0), P0[2], P0[3], P0[4], P0[5],     pw0[0] = PKW(P0, 0), pw0[1] = PKW(P0, 2), pw0); \
    VRD(4); SBAR(); GAPA(C1 = __builtin_amdgcn_mfma_f32_32x32x16_bf16(kf[1], qr[0], negm, 0, 0, 0), P0[6], P0[7], P0[8], P0[9],     pw0[2] = PKW(P0, 4), pw0[3] = PKW(P0, 6), pw0); \
    VRD(1); SBAR(); GAPA(C0 = __builtin_amdgcn_mfma_f32_32x32x16_bf16(kf[2], qr[1], C0, 0, 0, 0),   P0[10], P0[11], P0[12], P0[13], pw1[0] = PKW(P0, 8), pw1[1] = PKW(P0, 10), pw1); \
    VRD(5); SBAR(); GAPA(C1 = __builtin_amdgcn_mfma_f32_32x32x16_bf16(kf[3], qr[1], C1, 0, 0, 0),   P0[14], P0[15], P1[0], P1[1],   pw1[2] = PKW(P0, 12), pw1[3] = PKW(P0, 14), pw1); \
    VRD(2); SBAR(); GAPA(C0 = __builtin_amdgcn_mfma_f32_32x32x16_bf16(kf[4], qr[2], C0, 0, 0, 0),   P1[2], P1[3], P1[4], P1[5],     pw2[0] = PKW(P1, 0), pw2[1] = PKW(P1, 2), pw2); \
    VRD(6); SBAR(); GAPA(C1 = __builtin_amdgcn_mfma_f32_32x32x16_bf16(kf[5], qr[2], C1, 0, 0, 0),   P1[6], P1[7], P1[8], P1[9],     pw2[2] = PKW(P1, 4), pw2[3] = PKW(P1, 6), pw2); \
    VRD(3); SBAR(); GAPA(C0 = __builtin_amdgcn_mfma_f32_32x32x16_bf16(kf[6], qr[3], C0, 0, 0, 0),   P1[10], P1[11], P1[12], P1[13], pw3[0] = PKW(P1, 8), pw3[1] = PKW(P1, 10), pw3); \
    VRD(7); SBAR(); GAPA(C1 = __builtin_amdgcn_mfma_f32_32x32x16_bf16(kf[7], qr[3], C1, 0, 0, 0),   P1[14], P1[15], 0.f, 0.f,       pw3[2] = PKW(P1, 12), pw3[3] = PKW(P1, 14), pw3); \
    C0 = __builtin_amdgcn_mfma_f32_32x32x16_bf16(kx[0], qx, C0, 0, 0, 0); C1 = __builtin_amdgcn_mfma_f32_32x32x16_bf16(kx[1], qx, C1, 0, 0, 0); \
    l_reg += sacc; \
    if (GK) { DMA_K((t) + 3, sl_cur); } if (GV) { DMA_V((t) + 1, sl_next); } \
    CMASK(C0, C1, t); \
    { float a = MX3(C0[0], C0[1], C1[0]), b = MX3(C0[2], C0[3], C1[1]); a = MX3(a, C1[2], C1[3]); \
      _Pragma("unroll") for (int r = 4; r < 16; r += 4) { a = MX3(a, C0[r], C0[r + 1]); b = MX3(b, C0[r + 2], C0[r + 3]); a = MX3(a, C1[r], C1[r + 1]); b = MX3(b, C1[r + 2], C1[r + 3]); } \
      float rm = __builtin_fmaxf(a, b); { auto rr = __builtin_amdgcn_permlane32_swap(__float_as_uint(rm), __float_as_uint(rm), false, false); rm = __builtin_fmaxf(__uint_as_float(rr[0]), __uint_as_float(rr[1])); } \
      resc = false; \
      if (__builtin_expect(__any(rm > (float)THRL), 0)) { const float dl = __builtin_fmaxf(rm, 0.f); mhat += dl; \
        _Pragma("unroll") for (int r = 0; r < 16; ++r) { C0[r] -= dl; C1[r] -= dl; } \
        qx = make_qx(-mhat, hi); \
        const float f = __builtin_amdgcn_exp2f(-dl); l_reg *= f; if (hi == 0) wsf[r32] = f; resc = true; } } \
    SBAR(); \
    GAPB(o[0] = __builtin_amdgcn_mfma_f32_32x32x16_bf16(PAF(0), VFR(0), o[0], 0, 0, 0), C0, 0); \
    GAPB(o[1] = __builtin_amdgcn_mfma_f32_32x32x16_bf16(PAF(0), VFR(4), o[1], 0, 0, 0), C0, 4); \
    KRD(GL, 0); if (GL) { KXRD((t) + 1); SBAR(); } GAPB(o[0] = __builtin_amdgcn_mfma_f32_32x32x16_bf16(PAF(1), VFR(1), o[0], 0, 0, 0), C0, 8); \
    KRD(GL, 1); GAPB(o[1] = __builtin_amdgcn_mfma_f32_32x32x16_bf16(PAF(1), VFR(5), o[1], 0, 0, 0), C0, 12); \
    KRD(GL, 2); GAPB(o[0] = __builtin_amdgcn_mfma_f32_32x32x16_bf16(PAF(2), VFR(2), o[0], 0, 0, 0), C1, 0); \
    KRD(GL, 3); GAPB(o[1] = __builtin_amdgcn_mfma_f32_32x32x16_bf16(PAF(2), VFR(6), o[1], 0, 0, 0), C1, 4); \
    GAPB(o[0] = __builtin_amdgcn_mfma_f32_32x32x16_bf16(PAF(3), VFR(3), o[0], 0, 0, 0), C1, 8); \
    GAPB(o[1] = __builtin_amdgcn_mfma_f32_32x32x16_bf16(PAF(3), VFR(7), o[1], 0, 0, 0), C1, 12); \
    } while (0)
    int t = 1;
#undef CMASK
#define CMASK(P0, P1, t) do { } while (0)
    for (; t + 5 < NT; t += 2) {
        STEP(pB0, pB1, pA0, pA1, t, true, true, true);     WAIT_BAR(2); RESC(); ROT();
        STEP(pA0, pA1, pB0, pB1, t + 1, true, true, true); WAIT_BAR(2); RESC(); ROT();
    }
#undef CMASK
#define CMASK(P0, P1, t) do { int jb_ = (t) - (NT - 4); if (jb_ >= 0) cmask(P0, P1, jb_, qrel, hi); } while (0)
#define ENDW(tt) do { if ((tt) + 3 < NT) { WAIT_BAR(2); } else if ((tt) + 2 < NT) { WAIT_BAR(1); } else { WAIT_BAR(0); } } while (0)
    for (; t + 1 < NT; t += 2) {
        STEP(pB0, pB1, pA0, pA1, t, (t + 3 < NT), (t + 1 < NT), (t + 1 < NT));         ENDW(t);     RESC(); ROT();
        STEP(pA0, pA1, pB0, pB1, t + 1, (t + 4 < NT), (t + 2 < NT), (t + 2 < NT));     ENDW(t + 1); RESC(); ROT();
    }
    if (qb_next >= 0) { DMA_K(0, 0); DMA_K(1, SLOTB); DMA_K(2, 2 * SLOTB); }
    STEP(pB0, pB1, pA0, pA1, NT - 1, false, false, false); RESC();
    { float sacc = pB0[0] + pB0[1]; _Pragma("unroll") for (int r = 2; r < 16; ++r) sacc += pB0[r]; _Pragma("unroll") for (int r = 0; r < 16; ++r) sacc += pB1[r]; l_reg += sacc;
      pw0 = (u32x4){PKW(pB0, 0), PKW(pB0, 2), PKW(pB0, 4), PKW(pB0, 6)}; pw1 = (u32x4){PKW(pB0, 8), PKW(pB0, 10), PKW(pB0, 12), PKW(pB0, 14)}; pw2 = (u32x4){PKW(pB1, 0), PKW(pB1, 2), PKW(pB1, 4), PKW(pB1, 6)}; pw3 = (u32x4){PKW(pB1, 8), PKW(pB1, 10), PKW(pB1, 12), PKW(pB1, 14)};
      SBAR(); pv(o, vb0 + sl_cur, PAF(0), PAF(1), PAF(2), PAF(3)); }
    if (qb_next >= 0) { const bf16* Qn = Q + (rowbase + qb_next * QB + wid * QBLK) * KP + h * D;
        qn0 = *reinterpret_cast<const bf16x8*>(&Qn[(long)r32 * KP + 0 * 16 + hi * 8]); qn1 = *reinterpret_cast<const bf16x8*>(&Qn[(long)r32 * KP + 1 * 16 + hi * 8]);
        qn2 = *reinterpret_cast<const bf16x8*>(&Qn[(long)r32 * KP + 2 * 16 + hi * 8]); qn3 = *reinterpret_cast<const bf16x8*>(&Qn[(long)r32 * KP + 3 * 16 + hi * 8]); }
#undef PKW
#undef PAF
#undef VFR
#undef PIN
#undef MX3
#undef GAPA
#undef GAPB
#undef EX
#undef VRD
#undef KRD
#undef STEP
#undef ENDW
    { auto rr = __builtin_amdgcn_permlane32_swap(__float_as_uint(l_reg), __float_as_uint(l_reg), false, false); l_reg = __uint_as_float(rr[0]) + __uint_as_float(rr[1]); }
    if (hi == 0) wsf[32 + r32] = l_reg; asm volatile("s_waitcnt lgkmcnt(0)" ::: "memory");
    float rli[16];
#pragma unroll
    for (int r = 0; r < 16; ++r) rli[r] = __builtin_amdgcn_rcpf(wsf[32 + crow(r, hi)]);
    bf16* Ow = O + (rowbase + q0 + wid * QBLK) * OP + h * D;
    { bf16* stg = (bf16*)(shm + LDS_OST) + wid * 2048;
#pragma unroll
      for (int r = 0; r < 16; ++r) { const int orow = crow(r, hi);
#pragma unroll
          for (int d0 = 0; d0 < 2; ++d0) stg[orow * 64 + d0 * 32 + r32] = __float2bfloat16(o[d0][r] * rli[r]); }
      asm volatile("s_waitcnt lgkmcnt(0)" ::: "memory");
#pragma unroll
      for (int i = 0; i < 4; ++i) { const int row = i * 8 + (lane >> 3), ch = lane & 7; const u32x4 v = *(const u32x4*)(stg + row * 64 + ch * 8); *(u32x4*)(Ow + (long)row * OP + ch * 8) = v; } }
    asm volatile("s_waitcnt lgkmcnt(0)\n\ts_barrier" ::: "memory");
#undef DMA_K
#undef DMA_V
#undef KXRD
#undef CMASK
#undef START
#undef RESC
#undef ROT
}
#undef SBAR
#undef WAIT_BAR
}

#define LAS __attribute__((address_space(3)))
typedef unsigned short bf16;
typedef unsigned v4u __attribute__((ext_vector_type(4)));
typedef unsigned v2u __attribute__((ext_vector_type(2)));
typedef float f32x4 __attribute__((ext_vector_type(4)));
typedef float f32x2 __attribute__((ext_vector_type(2)));
#ifndef REP_0
#define REP_0 1
#endif
#ifndef REP_3
#define REP_3 1
#endif
#ifndef REP_4
#define REP_4 1
#endif
#ifndef REP_5
#define REP_5 1
#endif
#ifndef REP_6
#define REP_6 1
#endif
#ifndef REP_8
#define REP_8 1
#endif
#ifndef REP_9
#define REP_9 1
#endif
#ifndef REPA
#define REPA 1
#endif
#ifndef REP_1
#define REP_1 1
#endif
#ifndef REP_X
#define REP_X 1
#endif
#ifndef XSYNC
#define XSYNC 0
#endif
#ifndef REPC
#define REPC 1
#endif
#ifndef REP2
#define REP2 1
#endif
#ifndef ONLY
#define ONLY -1
#endif
#define PH(n) if (ONLY < 0 || ONLY == (n))
#ifndef CGFIRST
#define CGFIRST 0
#endif
constexpr int NWAVES = 8;
constexpr size_t MiB = 1u << 20;
constexpr size_t WS_WIN = 0, WS_WOUT = 5 * MiB, WS_WMQ = 7 * MiB, WS_WMKV = 9 * MiB, WS_WMO = 13 * MiB, WS_WGU = 15 * MiB, WS_WDN = 26 * MiB;
constexpr size_t WS_LOGF = 32 * MiB, WS_SS1 = 34 * MiB, WS_SS2 = 36 * MiB, WS_MEMN = 38 * MiB, WS_KVM = 46 * MiB;
constexpr size_t WS_BAR = 62 * MiB;  constexpr size_t WS_CNT = 62 * MiB + 32768, WS_SS3 = 62 * MiB + 65536;
constexpr size_t WS_XN = 64 * MiB;
constexpr size_t WS_Z = 128 * MiB;
constexpr size_t WS_QM = 128 * MiB, WS_P = 192 * MiB, WS_OM = 256 * MiB, WS_HMID = 128 * MiB;
constexpr size_t WS_CAT = 320 * MiB;
constexpr size_t WS_WMQ2 = 448 * MiB, WS_WMO2 = 452 * MiB;
constexpr size_t WS_WK = 384 * MiB, WS_VW = 416 * MiB;
constexpr size_t WS_END = 512 * MiB;
constexpr int RING_BYTES = 131072, XL_OFF = RING_BYTES, BARST_OFF = XL_OFF + 8192, LDS_BYTES = 147456;

struct Args { const float* in[19]; float* out; unsigned char* ws; };

__device__ __forceinline__ float wave_sum(float v) {
#pragma unroll
    for (int o = 1; o < 64; o <<= 1) v += __shfl_xor(v, o);
    return v;
}
__device__ __forceinline__ unsigned pk2(float lo, float hi) { return pg8::cvt_pk_bf16(lo, hi); }
__device__ __forceinline__ float bflo(unsigned w) { return __uint_as_float(w << 16); }
__device__ __forceinline__ float bfhi(unsigned w) { return __uint_as_float(w & 0xffff0000u); }

__device__ __forceinline__ void transpose_item(const float* W, int ldw, int K, const float* gain, bf16* WT, int kb, int scol0, int drow0, LAS float* scr, int lane) {
    const int k0 = 64 * kb;
#pragma unroll 4
    for (int i = 0; i < 16; ++i) { const int kk = 4 * i + (lane >> 4); f32x4 w = *(const f32x4*)(W + (size_t)(k0 + kk) * ldw + scol0 + 4 * (lane & 15)); if (gain) w = w * gain[k0 + kk];
        LAS float* d = scr + kk * 65 + 4 * (lane & 15); d[0] = w[0]; d[1] = w[1]; d[2] = w[2]; d[3] = w[3]; }
    asm volatile("s_waitcnt lgkmcnt(0)" ::: "memory");
    const int c = lane & 7;
#pragma unroll
    for (int j = 0; j < 8; ++j) { const int n = (lane >> 3) + 8 * j; const LAS float* p = scr + (8 * c) * 65 + n;
        v4u o; o.x = pk2(p[0 * 65], p[1 * 65]); o.y = pk2(p[2 * 65], p[3 * 65]); o.z = pk2(p[4 * 65], p[5 * 65]); o.w = pk2(p[6 * 65], p[7 * 65]);
        *(v4u*)(WT + (size_t)(drow0 + n) * K + k0 + 8 * c) = o; }
    asm volatile("s_waitcnt lgkmcnt(0)" ::: "memory");
}

#define XB_TMO      128
#define XB_XCNT(j)  (256  + 64 * (j))
#define XB_XSUB(j)  (1280 + 64 * (j))
#define XB_XGEN(j)  (2304 + 64 * (j))
#define XB_TOP      3328
#define XB_TOPGEN   3392
#define XCD_BAR_WORDS 3456
#define XB_SPIN_CAP (1u << 22)
__device__ __forceinline__ unsigned xb_ld(unsigned* p)              { return __hip_atomic_load(p, __ATOMIC_RELAXED, __HIP_MEMORY_SCOPE_AGENT); }
__device__ __forceinline__ unsigned xb_add(unsigned* p, unsigned v) { return __hip_atomic_fetch_add(p, v, __ATOMIC_RELAXED, __HIP_MEMORY_SCOPE_AGENT); }
__device__ __forceinline__ unsigned xb_xcc_id() { return (unsigned)__builtin_amdgcn_s_getreg((3 << 11) | 20) & 0xFu; }
#define XB_SPIN(cond, bar) do { unsigned _sp = 0; while (cond) { __builtin_amdgcn_s_sleep(1); \
    if ((++_sp & 255u) == 0u) { if (xb_ld(&(bar)[XB_TMO])) break; if (_sp > XB_SPIN_CAP) { atomicAdd(&(bar)[XB_TMO], 1u); break; } } } } while (0)
struct XcdBarrier { unsigned* bar; unsigned x; volatile LAS unsigned* st; };
__device__ __forceinline__ XcdBarrier xcd_barrier_post(unsigned* bar, volatile LAS unsigned* st) {
    XcdBarrier b; b.bar = bar; b.x = xb_xcc_id(); b.st = st;
    if (threadIdx.x == 0) (void)xb_add(&bar[XB_XCNT(b.x)], 1u);
    return b;
}
__device__ __forceinline__ void xcd_barrier_complete(unsigned* bar, unsigned x, unsigned& nloc, unsigned& nx) {
    const unsigned G = gridDim.x * gridDim.y * gridDim.z;
    unsigned sum, cnt, mine, sp = 0u;
    for (;;) {
        sum = 0u; cnt = 0u; mine = 0u;
#pragma unroll
        for (unsigned j = 0; j < 16; ++j) { const unsigned c = xb_ld(&bar[XB_XCNT(j)]); sum += c; cnt += (c > 0u) ? 1u : 0u; mine = (j == x) ? c : mine; }
        if (sum == G) break;
        __builtin_amdgcn_s_sleep(1);
        if ((++sp & 255u) == 0u) { if (xb_ld(&bar[XB_TMO])) break; if (sp > XB_SPIN_CAP) { atomicAdd(&bar[XB_TMO], 1u); break; } }
    }
    nloc = mine > 0u ? mine : 1u; nx = cnt > 0u ? cnt : 1u;
}
__device__ __forceinline__ void xcd_barrier(const XcdBarrier& b) {
    asm volatile("s_waitcnt vmcnt(0)" ::: "memory");
    __syncthreads();
    if (threadIdx.x == 0) {
        unsigned* bar = b.bar;
        __builtin_amdgcn_s_waitcnt(0);
        unsigned nloc = b.st[0], nx = b.st[1];
        if (nloc == 0u) { xcd_barrier_complete(bar, b.x, nloc, nx); b.st[0] = nloc; b.st[1] = nx; }
        const unsigned old = xb_add(&bar[XB_XSUB(b.x)], 1u);
        const unsigned gen = old / nloc;
        if (old + 1u == (gen + 1u) * nloc) {
            __builtin_amdgcn_fence(__ATOMIC_RELEASE, "agent");
            asm volatile("s_waitcnt vmcnt(0)" ::: "memory");
            const unsigned og = xb_add(&bar[XB_TOP], 1u);
            const unsigned tg = og / nx;
            if (og + 1u == (tg + 1u) * nx) xb_add(&bar[XB_TOPGEN], 1u);
            else XB_SPIN(xb_ld(&bar[XB_TOPGEN]) == tg, bar);
            __builtin_amdgcn_fence(__ATOMIC_ACQUIRE, "agent");
            xb_add(&bar[XB_XGEN(b.x)], 1u);
            asm volatile("s_waitcnt vmcnt(0)" ::: "memory");
        } else {
            XB_SPIN(xb_ld(&bar[XB_XGEN(b.x)]) == gen, bar);
            __builtin_amdgcn_fence(__ATOMIC_ACQUIRE, "agent");
            asm volatile("s_waitcnt vmcnt(0)" ::: "memory");
        }
    }
    __syncthreads();
}

#define XL_SUB(j)  (4096 + 64 * (j))
#define XL_GEN(j)  (5120 + 64 * (j))
#define XL_BAD     6144
__device__ __forceinline__ void xcd_local_barrier(const XcdBarrier& b) {
    asm volatile("s_waitcnt vmcnt(0)" ::: "memory");
    __syncthreads();
    if (threadIdx.x == 0) {
        unsigned* bar = b.bar; const unsigned nloc = b.st[0];
        const unsigned old = xb_add(&bar[XL_SUB(b.x)], 1u); const unsigned gen = old / nloc;
        if (old + 1u == (gen + 1u) * nloc) xb_add(&bar[XL_GEN(b.x)], 1u);
        else XB_SPIN(xb_ld(&bar[XL_GEN(b.x)]) == gen, bar);
        __builtin_amdgcn_fence(__ATOMIC_ACQUIRE, "agent");
        asm volatile("s_waitcnt vmcnt(0)" ::: "memory");
    }
    __syncthreads();
}

__global__ void __launch_bounds__(NWAVES * 64, 2) mk_fwd(Args args) {
    extern __shared__ __attribute__((aligned(16))) unsigned char lds_raw[];
    cg::grid_group grid = cg::this_grid();
    LAS unsigned char* lds = (LAS unsigned char*)lds_raw;
    LAS unsigned char* xl = lds + XL_OFF;
#define KARG(i) ({ unsigned long long p_; asm volatile("s_load_dwordx2 %0, %1, %2\n\ts_waitcnt lgkmcnt(0)" : "=s"(p_) : "s"((unsigned long long)__builtin_amdgcn_kernarg_segment_ptr()), "n"((i) * 8)); p_; })
#define IN(i) ((const float*)KARG(i))
#define WSB(off) ((bf16*)((unsigned char*)KARG(20) + (off)))
#define WSF(off) ((float*)((unsigned char*)KARG(20) + (off)))
#define OUTP ((float*)KARG(19))
    if (threadIdx.x < 2) ((volatile LAS unsigned*)(lds + BARST_OFF))[threadIdx.x] = 0u;
    __syncthreads();
    XcdBarrier xbar; xbar.bar = (unsigned*)((unsigned char*)KARG(20) + WS_BAR); xbar.x = 0; xbar.st = (volatile LAS unsigned*)(lds + BARST_OFF);
    if (!CGFIRST) {
        xbar.x = xb_xcc_id();
        if (threadIdx.x == 0) { const unsigned rk = xb_add(&xbar.bar[XB_XCNT(xbar.x)], 1u); ((volatile LAS unsigned*)(lds + BARST_OFF))[2] = rk; }
        __syncthreads();
    }
    int vb_cur = blockIdx.x;
#define GSYNC() xcd_barrier(xbar)
    if (!CGFIRST && gridDim.y == 4242u) grid.sync();
#define PHASE_VARS int t__ = threadIdx.x; asm volatile("" : "+v"(t__)); int b__ = vb_cur; asm volatile("" : "+s"(b__)); \
    const int tid = t__, lane = tid & 63, wave = __builtin_amdgcn_readfirstlane(tid >> 6); const int G = gridDim.x, bx = b__; \
    const int vcu = (G % 8 == 0) ? (bx % 8) * (G / 8) + bx / 8 : bx; const int gw = vcu * NWAVES + wave, NGW = G * NWAVES; (void)tid; (void)lane; (void)gw; (void)NGW; (void)vcu; (void)bx;

    for (int rp = 0; rp < REP_0; ++rp) { if (rp) grid.sync();
    PH(0) { PHASE_VARS
        if (CGFIRST && bx == 0) { unsigned* bw = (unsigned*)((unsigned char*)KARG(20) + WS_BAR); for (int i = tid; i < 16384; i += NWAVES * 64) __hip_atomic_store(bw + i, 0u, __ATOMIC_RELAXED, __HIP_MEMORY_SCOPE_AGENT); }
        const float* x = IN(0); const float* mem = IN(1); const float* g_mix = IN(2); const float* w_in = IN(3); const float* b_f = IN(4); const float* g_mem = IN(11);
        bf16* XN = WSB(WS_XN); bf16* MEMN = WSB(WS_MEMN); float* LOGF = WSF(WS_LOGF);
        LAS float* scr = (LAS float*)(lds + wave * 16640);
        constexpr int I_IN = 16 * 40, I_MKV = 16 * 32;
        for (int it = gw; it < I_IN + I_MKV; it += NGW) {
            int r = it;
            if (r < I_IN) { const int kb = r / 40, nb = r % 40; const int sc = 64 * nb; int dr = sc;
                if (sc < 1024) { const int i0 = sc < 512 ? sc : sc - 512; dr = 256 * (i0 / 128) + (i0 % 128) + (sc < 512 ? 0 : 128); }
                transpose_item(w_in, DIN, 1024, nullptr, WSB(WS_WIN), kb, sc, dr, scr, lane); continue; } r -= I_IN;
            { const int kb = r / 32, nb = r % 32; transpose_item(IN(13), 2048, 1024, nullptr, WSB(WS_WMKV), kb, 64 * nb, 64 * nb, scr, lane); }
        }
        __syncthreads();
        LAS float* wfT = (LAS float*)lds;
        for (int i = tid; i < 8192; i += NWAVES * 64) { const int k = i >> 3, h = i & 7; wfT[h * 1024 + k] = w_in[(size_t)k * DIN + 2560 + h]; }
        __syncthreads();
        f32x4 wfr[8][4];
#pragma unroll
        for (int h = 0; h < 8; ++h)
#pragma unroll
            for (int j = 0; j < 4; ++j) wfr[h][j] = *(const LAS f32x4*)(wfT + h * 1024 + 256 * j + 4 * lane);
        f32x4 gg[4];
#pragma unroll
        for (int j = 0; j < 4; ++j) gg[j] = ((const f32x4*)g_mix)[64 * j + lane];
        const int hsel = ((lane >> 5) & 1) * 4 + ((lane >> 4) & 1) * 2 + ((lane >> 3) & 1);
        const float bfl = b_f[hsel];
        {
            f32x4 cur[4], nxt[4];
            int m = gw;
            if (m < T) { const f32x4* xr = (const f32x4*)(x + (size_t)m * DM) + lane;
#pragma unroll
                for (int j = 0; j < 4; ++j) cur[j] = xr[64 * j]; }
#pragma unroll 1
            for (; m < T; m += NGW) {
                const int mn = m + NGW;
                if (mn < T) { const f32x4* xr = (const f32x4*)(x + (size_t)mn * DM) + lane;
#pragma unroll
                    for (int j = 0; j < 4; ++j) nxt[j] = xr[64 * j]; }
                float s = 0.f;
#pragma unroll
                for (int j = 0; j < 4; ++j) s += (cur[j][0] * cur[j][0] + cur[j][1] * cur[j][1]) + (cur[j][2] * cur[j][2] + cur[j][3] * cur[j][3]);
                float z[8];
#pragma unroll
                for (int h = 0; h < 8; ++h) z[h] = 0.f;
#pragma unroll
                for (int j = 0; j < 4; ++j) { cur[j] = cur[j] * gg[j];
#pragma unroll
                    for (int h = 0; h < 8; ++h) z[h] += (cur[j][0] * wfr[h][j][0] + cur[j][1] * wfr[h][j][1]) + (cur[j][2] * wfr[h][j][2] + cur[j][3] * wfr[h][j][3]); }
                const float rs = 1.0f / sqrtf(wave_sum(s) * (1.f / DM) + EPS);
                unsigned long long* o8 = (unsigned long long*)(XN + (size_t)m * DM) + lane;
#pragma unroll
                for (int j = 0; j < 4; ++j) { const f32x4 v = cur[j] * rs; o8[64 * j] = (unsigned long long)pk2(v[0], v[1]) | ((unsigned long long)pk2(v[2], v[3]) << 32); }
                float s4[4], s2[2], s1;
#pragma unroll
                for (int i = 0; i < 4; ++i) { const float send = (lane & 32) ? z[i] : z[4 + i], keep = (lane & 32) ? z[4 + i] : z[i]; s4[i] = keep + __shfl_xor(send, 32); }
#pragma unroll
                for (int i = 0; i < 2; ++i) { const float send = (lane & 16) ? s4[i] : s4[2 + i], keep = (lane & 16) ? s4[2 + i] : s4[i]; s2[i] = keep + __shfl_xor(send, 16); }
                { const float send = (lane & 8) ? s2[0] : s2[1], keep = (lane & 8) ? s2[1] : s2[0]; s1 = keep + __shfl_xor(send, 8); }
                s1 += __shfl_xor(s1, 4); s1 += __shfl_xor(s1, 2); s1 += __shfl_xor(s1, 1);
                if ((lane & 7) == 0) { const float zz = s1 * rs + bfl; LOGF[(size_t)m * 8 + hsel] = fminf(zz, 0.f) - log1pf(expf(-fabsf(zz))); }
#pragma unroll
                for (int j = 0; j < 4; ++j) cur[j] = nxt[j];
            }
        }
#pragma unroll
        for (int j = 0; j < 4; ++j) gg[j] = ((const f32x4*)g_mem)[64 * j + lane];
        for (int m = gw; m < NB * ML; m += NGW) {
            const f32x4* xr = (const f32x4*)(mem + (size_t)m * DM) + lane;
            f32x4 v[4]; float s = 0.f;
#pragma unroll
            for (int j = 0; j < 4; ++j) { v[j] = xr[64 * j]; s += (v[j][0] * v[j][0] + v[j][1] * v[j][1]) + (v[j][2] * v[j][2] + v[j][3] * v[j][3]); }
            const float rs = 1.0f / sqrtf(wave_sum(s) * (1.f / DM) + EPS);
            unsigned long long* o8 = (unsigned long long*)(MEMN + (size_t)m * DM) + lane;
#pragma unroll
            for (int j = 0; j < 4; ++j) { v[j] = v[j] * rs * gg[j]; o8[64 * j] = (unsigned long long)pk2(v[j][0], v[j][1]) | ((unsigned long long)pk2(v[j][2], v[j][3]) << 32); }
        }
    } }
    if (CGFIRST) { grid.sync(); xbar = xcd_barrier_post((unsigned*)((unsigned char*)KARG(20) + WS_BAR), (volatile LAS unsigned*)(lds + BARST_OFF)); } else GSYNC();
    bool xl_ok = false;
    if (!CGFIRST && gridDim.x == 256) {
        bool ok = true;
#pragma unroll
        for (unsigned j = 0; j < 16; ++j) { const unsigned cnt_ = xb_ld(&xbar.bar[XB_XCNT(j)]); ok = ok && (j < 8 ? cnt_ == 32u : cnt_ == 0u); }
        if (ok) { vb_cur = (int)(((volatile LAS unsigned*)(lds + BARST_OFF))[2] * 8u + xbar.x); xl_ok = true; }
    }
    vb_cur = __builtin_amdgcn_readfirstlane(vb_cur);

    PH(1) { PHASE_VARS
        pg8::Gemm g{WSB(WS_XN), WSB(WS_WIN), DM, DM, DM}; pg8::Sched2D S; S.init(T, ZP, G, bx, DM, DM);
        pg8::EpiZ E{WSB(WS_Z), ZP, attn_body::C2};
        for (int rp = 0; rp < REP_1; ++rp) pg8::gemm_phase(lds, xl, g, S, E);
    }
    PH(11) { PHASE_VARS
        pg8::Gemm g{WSB(WS_MEMN), WSB(WS_WMKV), DM, DM, DM}; pg8::Sched2D S; S.init(NB * ML, 2 * DM, G, bx, DM, DM);
        pg8::EpiBf16 E{WSB(WS_KVM), 2 * DM, 0, 0, 1.f};
        pg8::gemm_phase(lds, xl, g, S, E);
    }
    PH(13) { PHASE_VARS
        const int half = G / 2;
        if (bx >= half) {
            LAS float* scr = (LAS float*)(lds + wave * 16640);
            constexpr int I_OUT = 16 * 16, I_MQ = 1024, I_MO = 16 * 16, I_GU = 16 * 88, I_DN = 44 * 16;
            for (int it = (bx - half) * NWAVES + wave; it < I_OUT + I_MQ + I_MO + I_GU + I_DN; it += (G - half) * NWAVES) {
                int r = it;
                if (r < I_OUT) { const int kb = r / 16, nb = r % 16; transpose_item(IN(9), 1024, 1024, nullptr, WSB(WS_WOUT), kb, 64 * nb, 64 * nb, scr, lane); continue; } r -= I_OUT;
                if (r < I_MQ) {
                    const float gk = IN(10)[r]; const f32x4* wr_ = (const f32x4*)(IN(12) + (size_t)r * DM) + lane; unsigned long long* o8 = (unsigned long long*)(WSB(WS_WMQ2) + (size_t)r * 2048) + lane;
#pragma unroll
                    for (int j = 0; j < 4; ++j) { const f32x4 v = wr_[64 * j] * gk; o8[64 * j] = (unsigned long long)pk2(v[0], v[1]) | ((unsigned long long)pk2(v[2], v[3]) << 32); }
                    continue; } r -= I_MQ;
                if (r < I_MO) { const int kb = r / 16, nb = r % 16; transpose_item(IN(14), 1024, 2048, nullptr, WSB(WS_WMO2), kb, 64 * nb, 64 * nb, scr, lane); continue; } r -= I_MO;
                if (r < I_GU) { const int kb = r / 88, nb = r % 88; const int sc = 64 * nb; const int i0 = sc < DFF ? sc : sc - DFF; const int dr = 256 * (i0 / 128) + (i0 % 128) + (sc < DFF ? 0 : 128);
                    transpose_item(IN(16), 2 * DFF, 1024, IN(15), WSB(WS_WGU), kb, sc, dr, scr, lane); continue; } r -= I_GU;
                { const int kb = r / 16, nb = r % 16; transpose_item(IN(17), 1024, DFF, nullptr, WSB(WS_WDN), kb, 64 * nb, 64 * nb, scr, lane); }
            }
        }
    }
    GSYNC();

#define LSYNC() do { if (xl_ok) xcd_local_barrier(xbar); else GSYNC(); } while (0)

    for (int rep2 = 0; rep2 < REP2; ++rep2) {
    if (rep2) GSYNC();
    PH(2) { PHASE_VARS
        const float* LOGF = WSF(WS_LOGF); bf16* Z = WSB(WS_Z); bf16* CAT = WSB(WS_CAT);
        const float* conv_w = IN(5); const float* conv_b = IN(6); const float* ln_g = IN(7); const float* ln_b = IN(8);
        const int NV = G;
        for (int repa = 0; repa < REPA; ++repa)
        for (int v0 = vcu; v0 < 256; v0 += NV) {
            const int bh = v0 >> 1, b = bh >> 3, h = bh & 7, sel = v0 & 1;
            {
                LAS v4u* kxt = (LAS v4u*)(lds + attn_body::LDS_KX);
                LAS float* wtot = (LAS float*)(lds + attn_body::LDS_WS);
                const float* lf = LOGF + ((size_t)b * SEQ + 4 * tid) * 8 + h;
                const float a0 = lf[0], a1 = a0 + lf[8], a2 = a1 + lf[16], a3 = a2 + lf[24];
                float incl = a3;
#pragma unroll
                for (int o = 1; o < 64; o <<= 1) { const float n = __shfl_up(incl, o); if (lane >= o) incl += n; }
                if (lane == 63) wtot[wave] = incl;
                __syncthreads();
                float base = incl - a3;
                for (int w = 0; w < wave; ++w) base += wtot[w];
                const float cc[4] = {-(base + a0) * LOG2E, -(base + a1) * LOG2E, -(base + a2) * LOG2E, -(base + a3) * LOG2E};
#pragma unroll
                for (int j = 0; j < 4; ++j) { unsigned b0, b1, b2; attn_body::split3(cc[j], b0, b1, b2); kxt[4 * tid + j] = (v4u){b0 | (b1 << 16), b2 | (0x3F80u << 16), 0x3F803F80u, 0u}; }
                if (tid == 0) { unsigned zz = 0u; asm volatile("" : "+v"(zz)); kxt[SEQ] = (v4u){zz, zz, zz, zz}; }
                __syncthreads();
            }
            const attn_body::bf16* Zb = (const attn_body::bf16*)Z;
#ifndef NO_ATT
            attn_body::bf16x8 qn0 = {}, qn1 = {}, qn2 = {}, qn3 = {};
#pragma unroll 1
            for (int i = 0; i < 4; ++i) {
#define QB_OF(i_) (sel == 0 ? ((i_) == 0 ? 0 : (i_) == 1 ? 7 : (i_) == 2 ? 1 : 6) : ((i_) == 0 ? 2 : (i_) == 1 ? 5 : (i_) == 2 ? 3 : 4))
                const int qb = QB_OF(i), qbn = (i < 3) ? QB_OF(i + 1) : -1;
                attn_body::attn_unit<96>(b, h, qb, Zb + 1024, Zb + 1536, Zb + 2048, (attn_body::bf16*)CAT + 512, (char*)lds_raw, i == 0, qbn, qn0, qn1, qn2, qn3);
#undef QB_OF
            }
#endif
            __syncthreads();
        }
#ifndef NO_CONV
        {
            const int cp = tid & 255, th = tid >> 8;
            f32x2 w[31];
#pragma unroll
            for (int j = 0; j < 31; ++j) w[j] = *(const f32x2*)(conv_w + j * 512 + 2 * cp);
            const f32x2 cb = *(const f32x2*)(conv_b + 2 * cp);
            LAS float* yt = (LAS float*)lds;
            f32x4 lg0 = *(const f32x4*)(ln_g + 4 * lane), lg1 = *(const f32x4*)(ln_g + 256 + 4 * lane), lb0 = *(const f32x4*)(ln_b + 4 * lane), lb1 = *(const f32x4*)(ln_b + 256 + 4 * lane);
#define GLU2(uu) ((f32x2){bflo(uu), bfhi(uu)})
            for (int repc = 0; repc < REPC; ++repc)
            for (int kt = 0, tile = (G == 256) ? 64 * (vcu >> 5) + (vcu & 31) : vcu; tile < T / 64; ++kt, tile = (G == 256) ? ((kt < 2) ? 64 * (vcu >> 5) + 32 * kt + (vcu & 31) : T) : tile + G) {
                const int R0 = tile * 64, tl0 = R0 % SEQ;
                const bf16* zb = Z + (size_t)(R0 + 32 * th) * ZP + 2 * cp;
                f32x2 win[38]; unsigned ru[8];
#pragma unroll
                for (int i = 0; i < 38; ++i) win[i] = (f32x2){0.f, 0.f};
                if (tl0 + 32 * th > 0) {
#pragma unroll
                    for (int i = 0; i < 30; ++i) { const bf16* zr = zb + (long)(i - 30) * ZP; const unsigned uu = *(const unsigned*)zr; win[8 + i] = GLU2(uu); } }
#pragma unroll
                for (int i = 0; i < 8; ++i) { const bf16* zr = zb + (long)i * ZP; ru[i] = *(const unsigned*)zr; }
#pragma unroll 1
                for (int blk = 0; blk < 4; ++blk) {
                    const int tb = 32 * th + 8 * blk;
#pragma unroll
                    for (int i = 0; i < 30; ++i) win[i] = win[i + 8];
#pragma unroll
                    for (int i = 0; i < 8; ++i) win[30 + i] = GLU2(ru[i]);
                    if (blk < 3) {
#pragma unroll
                        for (int i = 0; i < 8; ++i) { const bf16* zr = zb + (long)(8 * blk + 8 + i) * ZP; ru[i] = *(const unsigned*)zr; } }
#pragma unroll
                    for (int o = 0; o < 8; ++o) { f32x2 y = cb;
#pragma unroll
                        for (int j = 0; j < 31; ++j) y += w[j] * win[o + j];
                        *(LAS f32x2*)(yt + (tb + o) * 512 + 2 * cp) = y; }
                }
                __syncthreads();
                {
                    f32x4 a[8], c[8]; float sm[8];
#pragma unroll
                    for (int k = 0; k < 8; ++k) { const int tok = wave * 8 + k; a[k] = *(const LAS f32x4*)(yt + tok * 512 + 4 * lane); c[k] = *(const LAS f32x4*)(yt + tok * 512 + 256 + 4 * lane);
                        sm[k] = ((a[k][0] + a[k][1]) + (a[k][2] + a[k][3])) + ((c[k][0] + c[k][1]) + (c[k][2] + c[k][3])); }
#pragma unroll
                    for (int o = 1; o < 64; o <<= 1) {
#pragma unroll
                        for (int k = 0; k < 8; ++k) sm[k] += __shfl_xor(sm[k], o); }
#pragma unroll
                    for (int k = 0; k < 8; ++k) { const float mu = sm[k] * (1.f / 512.f); a[k] = a[k] - mu; c[k] = c[k] - mu;
                        sm[k] = ((a[k][0] * a[k][0] + a[k][1] * a[k][1]) + (a[k][2] * a[k][2] + a[k][3] * a[k][3])) + ((c[k][0] * c[k][0] + c[k][1] * c[k][1]) + (c[k][2] * c[k][2] + c[k][3] * c[k][3])); }
#pragma unroll
                    for (int o = 1; o < 64; o <<= 1) {
#pragma unroll
                        for (int k = 0; k < 8; ++k) sm[k] += __shfl_xor(sm[k], o); }
#pragma unroll
                    for (int k = 0; k < 8; ++k) { const int tok = wave * 8 + k; const float rstd = 1.0f / sqrtf(sm[k] * (1.f / 512.f) + EPS);
                        f32x4 x = a[k] * rstd * lg0 + lb0, y = c[k] * rstd * lg1 + lb1;
#pragma unroll
                        for (int e = 0; e < 4; ++e) { x[e] = x[e] * __builtin_amdgcn_rcpf(1.f + __builtin_amdgcn_exp2f(-LOG2E * x[e])); y[e] = y[e] * __builtin_amdgcn_rcpf(1.f + __builtin_amdgcn_exp2f(-LOG2E * y[e])); }
                        bf16* orow = CAT + (size_t)(R0 + tok) * DM;
                        *(v2u*)(orow + 4 * lane) = (v2u){pk2(x[0], x[1]), pk2(x[2], x[3])}; *(v2u*)(orow + 256 + 4 * lane) = (v2u){pk2(y[0], y[1]), pk2(y[2], y[3])}; }
                }
                __syncthreads();
            }
        }
#endif
    }
    }
    for (int rpx = 0; rpx < REP_X; ++rpx) {
    PH(14) { PHASE_VARS
        const bf16* wsb = WSB(0);
        pg8::Gemm g{wsb, wsb, 2048, 2048, 256}; pg8::SchedKV S; S.init(G, bx, WS_KVM, WS_WMQ2, WS_WMO2);
        pg8::EpiBf16x2 E{WSB(WS_WK), WSB(WS_VW), DM, LOG2E / 16.f};
        pg8::gemm_phase(lds, xl, g, S, E);
    }
    }
    LSYNC();

    for (int rp = 0; rp < REP_3; ++rp) { if (rp) GSYNC();
    PH(3) { PHASE_VARS
        pg8::Gemm g{WSB(WS_CAT), WSB(WS_WOUT), DM, DM, DM}; pg8::Sched2D S; S.init(T, DM, G, bx, DM, DM);
        pg8::EpiRes<false> E{IN(0), WSB(WS_XN), WSF(WS_SS1)};
        pg8::gemm_phase(lds, xl, g, S, E);
    } }
    LSYNC();
    for (int rp = 0; rp < REP_4; ++rp) { if (rp) GSYNC();
    PH(4) { PHASE_VARS
        pg8::Gemm g{WSB(WS_XN), WSB(WS_WK), DM, DM, DM}; pg8::Sched2D S; S.init(T, DM, G, bx, DM, DM, (size_t)DM * DM * 2);
        pg8::EpiSoftmax E{WSB(WS_P), DM, WSF(WS_SS1)};
        pg8::gemm_phase(lds, xl, g, S, E);
    } }
    LSYNC();
    PH(7) { PHASE_VARS
        pg8::Gemm g{WSB(WS_P), WSB(WS_VW), DM, DM, DM}; pg8::Sched2D S; S.init(T, DM, G, bx, DM, DM, (size_t)DM * DM * 2);
        pg8::EpiRes<true> E{WSB(WS_XN), WSB(WS_XN), WSF(WS_SS2)};
        pg8::gemm_phase(lds, xl, g, S, E);
    }
    LSYNC();
    for (int rp = 0; rp < REP_8; ++rp) { if (rp) GSYNC();
    PH(8) { PHASE_VARS
        pg8::Gemm g{WSB(WS_XN), WSB(WS_WGU), DM, DM, DM}; pg8::Sched2D S; S.init(T, 2 * DFF, G, bx, DM, DM);
        pg8::EpiSwiGLU E{WSB(WS_HMID), DFF, WSF(WS_SS2)};
        pg8::gemm_phase(lds, xl, g, S, E);
    } }
    LSYNC();
    for (int rp = 0; rp < REP_9; ++rp) { if (rp) GSYNC();
    PH(9) { PHASE_VARS
        pg8::Gemm g{WSB(WS_HMID), WSB(WS_WDN), DFF, DFF, DFF}; pg8::Sched2D S; S.init(T, DM, G, bx, DFF, DFF);
        if (G == 256) {
            pg8::EpiFinal E{WSB(WS_XN), OUTP, IN(18), WSF(WS_SS3), (unsigned*)WSF(WS_CNT)};
            pg8::gemm_phase(lds, xl, g, S, E);
        } else {
            pg8::EpiResF32 E{WSB(WS_XN), OUTP};
            pg8::gemm_phase(lds, xl, g, S, E);
        }
    } }
    if (gridDim.x != 256) {
        GSYNC();
        { PHASE_VARS
            const float* g_final = IN(18); float* out = OUTP;
            f32x4 gg[4];
#pragma unroll
            for (int j = 0; j < 4; ++j) gg[j] = ((const f32x4*)g_final)[64 * j + lane];
            for (int m = gw; m < T; m += NGW) {
                f32x4* xr = (f32x4*)(out + (size_t)m * DM) + lane;
                f32x4 v[4]; float s = 0.f;
#pragma unroll
                for (int j = 0; j < 4; ++j) { v[j] = xr[64 * j]; s += (v[j][0] * v[j][0] + v[j][1] * v[j][1]) + (v[j][2] * v[j][2] + v[j][3] * v[j][3]); }
                const float rs = 1.0f / sqrtf(wave_sum(s) * (1.f / DM) + EPS);
#pragma unroll
                for (int j = 0; j < 4; ++j) xr[64 * j] = v[j] * rs * gg[j];
            }
        }
    }
    for (int xs = 0; xs < XSYNC; ++xs) GSYNC();
}

extern "C" void kernel_launch(void* const* d_in, const int* in_sizes, int n_in, void* d_out, int out_size, void* d_ws, size_t ws_size, hipStream_t stream) {
    static int grid = 0;
    if (grid == 0) {
        if (n_in != 19 || ws_size < WS_END) { fprintf(stderr, "kernel_launch: unexpected n_in %d / ws_size %zu\n", n_in, ws_size); grid = -1; return; }
        int dev = 0, cus = 0, per_cu = 0;
        (void)hipGetDevice(&dev); (void)hipDeviceGetAttribute(&cus, hipDeviceAttributeMultiprocessorCount, dev);
        (void)hipFuncSetAttribute((const void*)mk_fwd, hipFuncAttributeMaxDynamicSharedMemorySize, LDS_BYTES);
        (void)hipOccupancyMaxActiveBlocksPerMultiprocessor(&per_cu, (const void*)mk_fwd, NWAVES * 64, LDS_BYTES);
        if (per_cu < 1) { fprintf(stderr, "kernel_launch: occupancy query says %d blocks per CU\n", per_cu); per_cu = 1; }
        grid = cus * 1;
        (void)hipGetLastError();
    }
    if (grid < 0) return;
    if (!CGFIRST) (void)hipMemsetAsync((char*)d_ws + WS_BAR, 0, 65536, stream);
    Args a{};
    for (int i = 0; i < 19; ++i) a.in[i] = (const float*)d_in[i];
    a.out = (float*)d_out; a.ws = (unsigned char*)d_ws;
    void* kargs[] = {&a};
    hipError_t e = hipLaunchCooperativeKernel((const void*)mk_fwd, dim3(grid), dim3(NWAVES * 64), kargs, LDS_BYTES, stream);
    if (e != hipSuccess) fprintf(stderr, "cooperative launch failed: %s (grid %d)\n", hipGetErrorString(e), grid);
}
```
